# Optimizing an MI355X kernel written in HIP

```python
import math
import jax
import jax.numpy as jnp
from jax import lax
import numpy as np

D_MODEL = 2048
BATCH = 2
SEQ = 8192
DEPTH = 1

N_META = 16
BLOCK = 128
PAD = BLOCK - N_META
WINDOW = 128
HQ = 16
HKV = 4
Q_PER_KV = HQ // HKV
HD = 64
D_INNER = 2048
SSD_HEADDIM = 64
SSD_HEADS = D_INNER // SSD_HEADDIM
SSD_GROUPS = 4
HEADS_PER_GROUP = SSD_HEADS // SSD_GROUPS
D_STATE = 128
CONV_W = 4
CONV_DIM = D_INNER + 2 * SSD_GROUPS * D_STATE
MOE_GROUPS = 8
EXPERTS_PER_GROUP = 8
N_EXPERTS = MOE_GROUPS * EXPERTS_PER_GROUP
TOP_K = 2
D_EXPERT = 512
MOE_BLOCK = 128
LN_EPS = 1e-5
RMS_EPS = 1e-5
NEG_INF = -1e30
ALPHA = (2.0 * DEPTH) ** 0.25
BETA = (8.0 * DEPTH) ** -0.25
IN_SIZES = (HQ * HD, HKV * HD, HKV * HD, D_INNER, CONV_DIM, SSD_HEADS, D_MODEL, D_MODEL)
IN_DIM = sum(IN_SIZES)
IN_SPLITS = tuple(int(s) for s in np.cumsum(IN_SIZES)[:-1])

kernel_name = 'hybrid_swa_ssd_hmoe_deepnorm'


def layer_norm(x, g, b):
    xf = x.astype(jnp.float32)
    mu = jnp.mean(xf, axis=-1, keepdims=True)
    var = jnp.mean(jnp.square(xf - mu), axis=-1, keepdims=True)
    y = (xf - mu) * lax.rsqrt(var + LN_EPS) * g.astype(jnp.float32) + b.astype(jnp.float32)
    return y.astype(x.dtype)


def pad_front(a):
    return jnp.pad(a, [(0, 0), (PAD, 0)] + [(0, 0)] * (a.ndim - 2))


def sliding_window_attention_with_sinks(q, k, v, sinks):
    b, lp = q.shape[0], q.shape[1]
    nb = lp // BLOCK
    qb = q.reshape(b, nb, BLOCK, HKV, Q_PER_KV, HD)
    kb = k.reshape(b, nb, BLOCK, HKV, HD)
    vb = v.reshape(b, nb, BLOCK, HKV, HD)

    def band(t):
        prev = jnp.concatenate([jnp.zeros_like(t[:, :1]), t[:, :-1]], axis=1)
        return jnp.concatenate([prev, t], axis=2)

    k_band, v_band = band(kb), band(vb)
    k_meta = k[:, PAD:PAD + N_META]
    v_meta = v[:, PAD:PAD + N_META]
    scale = HD ** -0.5
    s_band = jnp.einsum('bnqhgd,bnshd->bnhgqs', qb, k_band).astype(jnp.float32) * scale
    s_meta = jnp.einsum('bnqhgd,bmhd->bnhgqm', qb, k_meta).astype(jnp.float32) * scale
    blk = jnp.arange(nb)[:, None]
    q_pos = blk * BLOCK + jnp.arange(BLOCK)[None, :] - PAD
    k_pos = (blk - 1) * BLOCK + jnp.arange(2 * BLOCK)[None, :] - PAD
    dist = q_pos[:, :, None] - k_pos[:, None, :]
    band_ok = (k_pos[:, None, :] >= N_META) & (dist >= 0) & (dist < WINDOW)
    meta_ok = jnp.arange(N_META)[None, None, :] <= q_pos[:, :, None]
    s_band = jnp.where(band_ok[None, :, None, None], s_band, NEG_INF)
    s_meta = jnp.where(meta_ok[None, :, None, None], s_meta, NEG_INF)
    sink = jnp.broadcast_to(sinks.astype(jnp.float32).reshape(1, 1, HKV, Q_PER_KV, 1, 1),
                            s_band.shape[:-1] + (1,))
    probs = jax.nn.softmax(jnp.concatenate([s_band, s_meta, sink], axis=-1), axis=-1).astype(v.dtype)
    out = (jnp.einsum('bnhgqs,bnshd->bnqhgd', probs[..., :2 * BLOCK], v_band)
           + jnp.einsum('bnhgqm,bmhd->bnqhgd', probs[..., 2 * BLOCK:2 * BLOCK + N_META], v_meta))
    return out.reshape(b, lp, HQ * HD)


def causal_depthwise_conv(x, w, bias):
    y = lax.conv_general_dilated(x, w[:, None, :], window_strides=(1,), padding=[(CONV_W - 1, 0)],
                                 dimension_numbers=('NWC', 'WIO', 'NWC'),
                                 feature_group_count=x.shape[-1])
    return y + bias


def ssd_chunked(xh, dt, a, bm, cm):
    b, lp = xh.shape[0], xh.shape[1]
    nc = lp // BLOCK
    xdt = (xh * dt[..., None]).reshape(b, nc, BLOCK, SSD_GROUPS, HEADS_PER_GROUP, SSD_HEADDIM)
    adt = (dt * a).reshape(b, nc, BLOCK, SSD_GROUPS, HEADS_PER_GROUP).transpose(0, 3, 4, 1, 2)
    a_cs = jnp.cumsum(adt, axis=-1)
    bc = bm.reshape(b, nc, BLOCK, SSD_GROUPS, D_STATE)
    cc = cm.reshape(b, nc, BLOCK, SSD_GROUPS, D_STATE)
    causal = jnp.tril(jnp.ones((BLOCK, BLOCK), dtype=bool))
    seg = a_cs[..., :, None] - a_cs[..., None, :]
    decay_ls = jnp.exp(jnp.where(causal, seg, -jnp.inf))
    cb = jnp.einsum('bclgn,bcsgn->bcgls', cc, bc)
    y_diag = jnp.einsum('bcgls,bgrcls,bcsgrp->bclgrp', cb, decay_ls, xdt)
    decay_to_end = jnp.exp(a_cs[..., -1:] - a_cs)
    states = jnp.einsum('bclgn,bgrcl,bclgrp->bcgrpn', bc, decay_to_end, xdt)
    chunk_decay = jnp.exp(a_cs[..., -1])

    def step(h, inp):
        s_c, d_c = inp
        return h * d_c[..., None, None] + s_c, h

    h0 = jnp.zeros((b, SSD_GROUPS, HEADS_PER_GROUP, SSD_HEADDIM, D_STATE), xh.dtype)
    _, prev = lax.scan(step, h0, (jnp.moveaxis(states, 1, 0), jnp.moveaxis(chunk_decay, -1, 0)))
    prev = jnp.moveaxis(prev, 0, 1)
    y_off = jnp.einsum('bclgn,bcgrpn,bgrcl->bclgrp', cc, prev, jnp.exp(a_cs))
    return (y_diag + y_off).reshape(b, lp, SSD_HEADS, SSD_HEADDIM)


def gated_rmsnorm(y, z, g):
    b, l, _ = y.shape
    yz = (y * jax.nn.silu(z.astype(jnp.float32))).reshape(b, l, SSD_GROUPS, D_INNER // SSD_GROUPS)
    yz = yz * lax.rsqrt(jnp.mean(jnp.square(yz), axis=-1, keepdims=True) + RMS_EPS)
    return yz.reshape(b, l, D_INNER) * g.astype(jnp.float32)


def hybrid_mixer(u, w_in, conv_w, conv_b, dt_bias, a_log, d_skip, ssd_norm_g, sinks,
                 w_br_attn, w_br_ssd, w_o):
    b, l, _ = u.shape
    q, k, v, z, xbc, dt_raw, g_attn, g_ssd = jnp.split(u @ w_in, IN_SPLITS, axis=-1)
    q = pad_front(q.reshape(b, l, HKV, Q_PER_KV, HD))
    k = pad_front(k.reshape(b, l, HKV, HD))
    v = pad_front(v.reshape(b, l, HKV, HD))
    attn = sliding_window_attention_with_sinks(q, k, v, sinks)[:, PAD:]
    xbc = jax.nn.silu(causal_depthwise_conv(xbc, conv_w, conv_b))
    xs, bs, cs = jnp.split(xbc, [D_INNER, D_INNER + SSD_GROUPS * D_STATE], axis=-1)
    dt = jax.nn.softplus(dt_raw.astype(jnp.float32) + dt_bias.astype(jnp.float32))
    a = -jnp.exp(a_log.astype(jnp.float32))
    xh = xs.reshape(b, l, SSD_HEADS, SSD_HEADDIM).astype(jnp.float32)
    y = ssd_chunked(pad_front(xh), pad_front(dt), a,
                    pad_front(bs.reshape(b, l, SSD_GROUPS, D_STATE).astype(jnp.float32)),
                    pad_front(cs.reshape(b, l, SSD_GROUPS, D_STATE).astype(jnp.float32)))[:, PAD:]
    y = y + d_skip.astype(jnp.float32)[:, None] * xh
    y = gated_rmsnorm(y.reshape(b, l, D_INNER), z, ssd_norm_g).astype(u.dtype)
    merged = jax.nn.sigmoid(g_attn) * (attn @ w_br_attn) + jax.nn.sigmoid(g_ssd) * (y @ w_br_ssd)
    return merged @ w_o


def hierarchical_moe(h, w_rg, b_rg, w_re, b_re, w_gate, w_up, w_down):
    b, l, d = h.shape
    t = b * l
    xt = h.reshape(t, d)
    p_group = jax.nn.softmax((xt @ w_rg).astype(jnp.float32) + b_rg.astype(jnp.float32), axis=-1)
    p_top, g_idx = lax.top_k(p_group, 1)
    le = ((xt @ w_re).astype(jnp.float32) + b_re.astype(jnp.float32)).reshape(t, MOE_GROUPS, EXPERTS_PER_GROUP)
    le_sel = jnp.take_along_axis(le, g_idx[:, :, None], axis=1)[:, 0]
    w_in_grp, e_in_grp = lax.top_k(jax.nn.softmax(le_sel, axis=-1), TOP_K)
    w_in_grp = w_in_grp / jnp.sum(w_in_grp, axis=-1, keepdims=True)
    weight = (p_top * w_in_grp).astype(h.dtype)
    expert = g_idx * EXPERTS_PER_GROUP + e_in_grp
    n = t * TOP_K
    nb = -(-n // MOE_BLOCK) + N_EXPERTS
    e_flat = expert.reshape(n)
    w_flat = weight.reshape(n)
    tok_flat = jnp.arange(n, dtype=jnp.int32) // TOP_K
    order = jnp.argsort(e_flat, stable=True)
    e_sorted = e_flat[order]
    counts = jnp.zeros((N_EXPERTS,), jnp.int32).at[e_flat].add(1)
    start = jnp.cumsum(counts) - counts
    pcounts = (counts + MOE_BLOCK - 1) // MOE_BLOCK * MOE_BLOCK
    pend = jnp.cumsum(pcounts)
    pstart = pend - pcounts
    dest = pstart[e_sorted] + jnp.arange(n, dtype=jnp.int32) - start[e_sorted]
    buf_tok = jnp.full((nb * MOE_BLOCK,), t, jnp.int32).at[dest].set(tok_flat[order])
    buf_w = jnp.zeros((nb * MOE_BLOCK,), h.dtype).at[dest].set(w_flat[order])
    blk_e = jnp.minimum(jnp.searchsorted(pend, jnp.arange(nb, dtype=jnp.int32) * MOE_BLOCK, side='right'),
                        N_EXPERTS - 1).astype(jnp.int32)
    x_pad = jnp.concatenate([xt, jnp.zeros((1, d), xt.dtype)], axis=0)
    xb = x_pad[buf_tok].reshape(nb, MOE_BLOCK, d)

    def expert_block(args):
        xblk, e = args
        hid = jax.nn.silu(xblk @ w_gate[e]) * (xblk @ w_up[e])
        return hid @ w_down[e]

    yb = lax.map(expert_block, (xb, blk_e)).reshape(nb * MOE_BLOCK, d) * buf_w[:, None]
    out = jnp.zeros((t + 1, d), h.dtype).at[buf_tok].add(yb)[:t]
    return out.reshape(b, l, d)


def setup_inputs(seed: int = 0) -> dict:
    key = jax.random.key(seed)
    ks = jax.random.split(key, 26)
    f32 = jnp.float32

    def nrm(k, shape, scale):
        return jax.random.normal(k, shape, f32) * scale

    dt = jnp.exp(jax.random.uniform(ks[7], (DEPTH, SSD_HEADS), f32, math.log(1e-3), math.log(1e-1)))
    return {
        'x': nrm(ks[0], (BATCH, SEQ, D_MODEL), 1.0),
        'meta_tokens': nrm(ks[1], (N_META, D_MODEL), 1.0),
        'ln_emb_g': 1.0 + nrm(ks[2], (D_MODEL,), 0.02),
        'ln_emb_b': nrm(ks[3], (D_MODEL,), 0.02),
        'w_in': nrm(ks[4], (DEPTH, D_MODEL, IN_DIM), D_MODEL ** -0.5),
        'conv_w': nrm(ks[5], (DEPTH, CONV_W, CONV_DIM), CONV_W ** -0.5),
        'conv_b': nrm(ks[6], (DEPTH, CONV_DIM), 0.01),
        'dt_bias': dt + jnp.log(-jnp.expm1(-dt)),
        'a_log': jnp.log(jax.random.uniform(ks[8], (DEPTH, SSD_HEADS), f32, 1.0, 16.0)),
        'd_skip': 1.0 + nrm(ks[9], (DEPTH, SSD_HEADS), 0.02),
        'ssd_norm_g': 1.0 + nrm(ks[10], (DEPTH, D_INNER), 0.02),
        'sinks': nrm(ks[11], (DEPTH, HQ), 0.5),
        'w_br_attn': nrm(ks[12], (DEPTH, HQ * HD, D_MODEL), (HQ * HD) ** -0.5),
        'w_br_ssd': nrm(ks[13], (DEPTH, D_INNER, D_MODEL), D_INNER ** -0.5),
        'w_o': nrm(ks[14], (DEPTH, D_MODEL, D_MODEL), BETA * D_MODEL ** -0.5),
        'ln1_g': 1.0 + nrm(ks[15], (DEPTH, D_MODEL), 0.02),
        'ln1_b': nrm(ks[16], (DEPTH, D_MODEL), 0.02),
        'w_router_group': nrm(ks[17], (DEPTH, D_MODEL, MOE_GROUPS), D_MODEL ** -0.5),
        'b_router_group': nrm(ks[18], (DEPTH, MOE_GROUPS), 0.01),
        'w_router_expert': nrm(ks[19], (DEPTH, D_MODEL, N_EXPERTS), D_MODEL ** -0.5),
        'b_router_expert': nrm(ks[20], (DEPTH, N_EXPERTS), 0.01),
        'w_gate': nrm(ks[21], (DEPTH, N_EXPERTS, D_MODEL, D_EXPERT), D_MODEL ** -0.5),
        'w_up': nrm(ks[22], (DEPTH, N_EXPERTS, D_MODEL, D_EXPERT), D_MODEL ** -0.5),
        'w_down': nrm(ks[23], (DEPTH, N_EXPERTS, D_EXPERT, D_MODEL), BETA * D_EXPERT ** -0.5),
        'ln2_g': 1.0 + nrm(ks[24], (DEPTH, D_MODEL), 0.02),
        'ln2_b': nrm(ks[25], (DEPTH, D_MODEL), 0.02),
    }


def reference(x, meta_tokens, ln_emb_g, ln_emb_b, w_in, conv_w, conv_b, dt_bias, a_log, d_skip,
              ssd_norm_g, sinks, w_br_attn, w_br_ssd, w_o, ln1_g, ln1_b, w_router_group,
              b_router_group, w_router_expert, b_router_expert, w_gate, w_up, w_down, ln2_g, ln2_b):
    b = x.shape[0]
    meta = jnp.broadcast_to(meta_tokens.astype(x.dtype)[None], (b, N_META, x.shape[-1]))
    h = layer_norm(jnp.concatenate([meta, x], axis=1), ln_emb_g, ln_emb_b)
    for i in range(DEPTH):
        mix = hybrid_mixer(h, w_in[i], conv_w[i], conv_b[i], dt_bias[i], a_log[i], d_skip[i],
                           ssd_norm_g[i], sinks[i], w_br_attn[i], w_br_ssd[i], w_o[i])
        h = layer_norm(ALPHA * h + mix, ln1_g[i], ln1_b[i])
        ffn = hierarchical_moe(h, w_router_group[i], b_router_group[i], w_router_expert[i],
                               b_router_expert[i], w_gate[i], w_up[i], w_down[i])
        h = layer_norm(ALPHA * h + ffn, ln2_g[i], ln2_b[i])
    return h[:, N_META:]
```

```cpp
#include <hip/hip_runtime.h>
#include <stdint.h>
#include <stdio.h>

typedef unsigned short bf16_t;
typedef short bf16x8 __attribute__((ext_vector_type(8)));
typedef float f32x16 __attribute__((ext_vector_type(16)));
#define DEVINL __device__ __forceinline__

constexpr int BATCH = 2, SEQ = 8192, DM = 2048, NMETA = 16;
constexpr int LP = 8320;
constexpr int MP = BATCH * LP;
constexpr int MR = BATCH * SEQ;
constexpr int NIN = 11008;
constexpr int C_Q = 0, C_K = 1024, C_V = 1280, C_Z = 1536, C_X = 3584, C_B = 5632, C_C = 6144, C_GA = 6656, C_GS = 8704, C_DT = 10752;
constexpr int HQ = 16, HKV = 4, HD = 64;
constexpr int SH = 32, SP = 64, SG = 4, SN = 128;
constexpr int NE = 64, DE = 512;
constexpr int MOE_TILE = 256, MOE_MAXT = 192, MOE_MAXPOS = MOE_MAXT * MOE_TILE;
constexpr float LN_EPS = 1e-5f, RMS_EPS = 1e-5f;
constexpr float ALPHA = 1.189207115002721f;

constexpr size_t MiB = 1ull << 20;
constexpr size_t WS_CTL = 0;
constexpr size_t CTL_BYTES = 1 * MiB;
constexpr size_t OFF_CNT = 64 * 1024;
constexpr size_t OFF_SS = 128 * 1024;
constexpr size_t WS_MISC = 1 * MiB;
constexpr size_t OFF_ROWSTAT = WS_MISC;
constexpr size_t OFF_TILE_E = WS_MISC + 256 * 1024;
constexpr size_t WS_WIN = 2 * MiB;
constexpr size_t WS_WBRA = 45 * MiB;
constexpr size_t WS_WBRS = 49 * MiB;
constexpr size_t WS_WO = 57 * MiB;
constexpr size_t WS_WGU = 65 * MiB;
constexpr size_t WS_WDN = 321 * MiB;
constexpr size_t WS_H0 = 449 * MiB;
constexpr size_t WS_T1S = 449 * MiB;
constexpr size_t WS_ZP = 514 * MiB;
constexpr size_t WS_U = 514 * MiB;
constexpr size_t WS_GU = 514 * MiB;
constexpr size_t WS_H1 = 642 * MiB;
constexpr size_t WS_H1B = 770 * MiB;
constexpr size_t WS_LIST = 834 * MiB;
constexpr size_t WS_LISTW = 838 * MiB;
constexpr size_t WS_POS = 842 * MiB;
constexpr size_t WS_HID = 844 * MiB;
constexpr size_t WS_AY = 864 * MiB;
constexpr size_t WS_MERGED = 960 * MiB;
constexpr size_t WS_Y = 892 * MiB;
constexpr size_t WS_END = 1024 * MiB;

DEVINL float bf2f(bf16_t h) { return __uint_as_float(((unsigned)h) << 16); }
DEVINL bf16_t f2bf(float f) { unsigned u = __float_as_uint(f); return (bf16_t)((u + 0x7fffu + ((u >> 16) & 1u)) >> 16); }
DEVINL unsigned pk2(float lo, float hi) { return (unsigned)f2bf(lo) | ((unsigned)f2bf(hi) << 16); }
DEVINL float wave_sum(float v) {
#pragma unroll
    for (int o = 1; o < 64; o <<= 1) v += __shfl_xor(v, o);
    return v;
}
DEVINL float sigmoidf(float x) { return 1.f / (1.f + __expf(-x)); }
DEVINL float siluf(float x) { return x / (1.f + __expf(-x)); }
DEVINL int prow_of(int r) { return (r >> 13) * LP + 128 + (r & (SEQ - 1)); }

__global__ void __launch_bounds__(256) k_transpose(const float* __restrict__ src, const float* __restrict__ src2, int ld, size_t src_bs,
                                                   bf16_t* __restrict__ dst, int K, size_t dst_bs, int mode) {
    __shared__ float tile[32][33];
    const int kt = blockIdx.x, nt = blockIdx.y, e = blockIdx.z;
    const int tx = threadIdx.x & 31, ty = threadIdx.x >> 5;
    const float* s = src + (size_t)e * src_bs;
    int c0 = nt * 32;
    bool zero = false;
    if (mode == 1) {
        const int n = nt * 32;
        if (n < 6656) c0 = n; else if (n < 10752) c0 = n + 32; else if (n < 10784) c0 = n - 4096; else zero = true;
    } else if (mode == 2) {
        const int pn = nt >> 3, w = nt & 7;
        if (w >= 4) s = src2 + (size_t)e * src_bs;
        c0 = pn * 128 + (w & 3) * 32;
    }
    const int k0 = kt * 32;
#pragma unroll
    for (int i = 0; i < 4; ++i) tile[ty + 8 * i][tx] = zero ? 0.f : s[(size_t)(k0 + ty + 8 * i) * ld + c0 + tx];
    __syncthreads();
    bf16_t* d = dst + (size_t)e * dst_bs;
#pragma unroll
    for (int i = 0; i < 4; ++i) { const int n = ty + 8 * i; d[(size_t)(nt * 32 + n) * K + k0 + tx] = f2bf(tile[tx][n]); }
}

__global__ void __launch_bounds__(256) k_ln0(const float* __restrict__ x, const float* __restrict__ meta, const float* __restrict__ g, const float* __restrict__ bt,
                                             bf16_t* __restrict__ H0, float* __restrict__ rowstat) {
    const int wave = threadIdx.x >> 6, lane = threadIdx.x & 63;
    const int R = blockIdx.x * 4 + wave; if (R >= MP) return;
    const int b = R / LP, p = R % LP;
    uint2* orow = (uint2*)(H0 + (size_t)R * DM);
    if (p < 112) {
#pragma unroll
        for (int j = 0; j < 8; ++j) orow[lane + 64 * j] = make_uint2(0u, 0u);
        return;
    }
    const float* src = p < 128 ? meta + (size_t)(p - 112) * DM : x + ((size_t)b * SEQ + (p - 128)) * DM;
    float4 v[8]; float s = 0.f;
#pragma unroll
    for (int j = 0; j < 8; ++j) { v[j] = ((const float4*)src)[lane + 64 * j]; s += (v[j].x + v[j].y) + (v[j].z + v[j].w); }
    const float mean = wave_sum(s) * (1.f / DM); float q = 0.f;
#pragma unroll
    for (int j = 0; j < 8; ++j) { v[j].x -= mean; v[j].y -= mean; v[j].z -= mean; v[j].w -= mean; q += (v[j].x * v[j].x + v[j].y * v[j].y) + (v[j].z * v[j].z + v[j].w * v[j].w); }
    const float rstd = 1.f / sqrtf(wave_sum(q) * (1.f / DM) + LN_EPS);
#pragma unroll
    for (int j = 0; j < 8; ++j) {
        const float4 gg = ((const float4*)g)[lane + 64 * j], bb = ((const float4*)bt)[lane + 64 * j];
        orow[lane + 64 * j] = make_uint2(pk2(v[j].x * rstd * gg.x + bb.x, v[j].y * rstd * gg.y + bb.y), pk2(v[j].z * rstd * gg.z + bb.z, v[j].w * rstd * gg.w + bb.w));
    }
    if (p >= 128 && lane == 0) { const int r = b * SEQ + p - 128; rowstat[2 * r] = mean; rowstat[2 * r + 1] = rstd; }
}

template <class Epi>
__global__ void __launch_bounds__(256) k_gemm(const bf16_t* __restrict__ A, int lda, const int* __restrict__ arow, const bf16_t* __restrict__ Bt, int ldb, int K,
                                              const int* __restrict__ tile_e, size_t b_stride, Epi epi) {
    const int wave = threadIdx.x >> 6, lane = threadIdx.x & 63, wr = wave >> 1, wc = wave & 1;
    const int row0 = blockIdx.y * 128 + wr * 64, col0 = blockIdx.x * 128 + wc * 64;
    const bf16_t* Bb = Bt;
    if (tile_e) { const int e = tile_e[blockIdx.y >> 1]; if (e < 0) return; Bb += (size_t)e * b_stride; }
    const int l31 = lane & 31, kh = (lane >> 5) * 8;
    const bf16_t* ap[2]; const bf16_t* bp[2];
#pragma unroll
    for (int i = 0; i < 2; ++i) { const int r = row0 + i * 32 + l31; int sr = arow ? arow[r] : r; if (sr < 0) sr = 0; ap[i] = A + (size_t)sr * lda + kh; }
#pragma unroll
    for (int j = 0; j < 2; ++j) bp[j] = Bb + (size_t)(col0 + j * 32 + l31) * ldb + kh;
    f32x16 acc[2][2];
#pragma unroll
    for (int i = 0; i < 2; ++i)
#pragma unroll
        for (int j = 0; j < 2; ++j)
#pragma unroll
            for (int r = 0; r < 16; ++r) acc[i][j][r] = 0.f;
#pragma unroll 4
    for (int k = 0; k < K; k += 16) {
        const bf16x8 a0 = *(const bf16x8*)(ap[0] + k), a1 = *(const bf16x8*)(ap[1] + k);
        const bf16x8 b0 = *(const bf16x8*)(bp[0] + k), b1 = *(const bf16x8*)(bp[1] + k);
        acc[0][0] = __builtin_amdgcn_mfma_f32_32x32x16_bf16(a0, b0, acc[0][0], 0, 0, 0);
        acc[0][1] = __builtin_amdgcn_mfma_f32_32x32x16_bf16(a0, b1, acc[0][1], 0, 0, 0);
        acc[1][0] = __builtin_amdgcn_mfma_f32_32x32x16_bf16(a1, b0, acc[1][0], 0, 0, 0);
        acc[1][1] = __builtin_amdgcn_mfma_f32_32x32x16_bf16(a1, b1, acc[1][1], 0, 0, 0);
    }
#pragma unroll
    for (int i = 0; i < 2; ++i)
#pragma unroll
        for (int j = 0; j < 2; ++j)
#pragma unroll
            for (int r = 0; r < 16; ++r) {
                const int row = row0 + i * 32 + (r & 3) + 8 * (r >> 2) + 4 * (lane >> 5), col = col0 + j * 32 + l31;
                epi(row, col, acc[i][j][r]);
            }
}

struct EpiStoreBf16 { bf16_t* C; size_t ldc; DEVINL void operator()(int row, int col, float v) const { C[(size_t)row * ldc + col] = f2bf(v); } };
struct EpiBrA {
    bf16_t* T1S; const bf16_t* ZP;
    DEVINL void operator()(int row, int col, float v) const { const float ga = bf2f(ZP[(size_t)prow_of(row) * NIN + C_GA + col]); T1S[(size_t)row * DM + col] = f2bf(sigmoidf(ga) * v); }
};
struct EpiBrS {
    const bf16_t* T1S; const bf16_t* ZP; bf16_t* MG;
    DEVINL void operator()(int row, int col, float v) const { const float gs = bf2f(ZP[(size_t)prow_of(row) * NIN + C_GS + col]); MG[(size_t)row * DM + col] = f2bf(bf2f(T1S[(size_t)row * DM + col]) + sigmoidf(gs) * v); }
};
struct EpiWo {
    float* U; const float* x; const float* rowstat; const float* g; const float* bt;
    DEVINL void operator()(int row, int col, float v) const {
        const float h0 = (x[(size_t)row * DM + col] - rowstat[2 * row]) * rowstat[2 * row + 1] * g[col] + bt[col];
        U[(size_t)row * DM + col] = ALPHA * h0 + v;
    }
};
struct EpiDown {
    bf16_t* Y; const int* pos_ent; const float* pos_w;
    DEVINL void operator()(int row, int col, float v) const { const int ent = pos_ent[row]; if (ent >= 0) Y[(size_t)ent * DM + col] = f2bf(pos_w[row] * v); }
};

__global__ void __launch_bounds__(256) k_attn_naive(const bf16_t* __restrict__ ZP, const float* __restrict__ sinks, bf16_t* __restrict__ AY) {
    const int wave = threadIdx.x >> 6, lane = threadIdx.x & 63;
    const int item = blockIdx.x * 4 + wave;
    const int kvh = item & 3, r = item >> 2, b = r >> 13, s = r & (SEQ - 1);
    const int g = lane >> 4, j = lane & 15, hq = kvh * 4 + g;
    const size_t rowb = (size_t)b * LP;
    const bf16_t* qp = ZP + (rowb + 128 + s) * NIN + C_Q + hq * 64 + 4 * j;
    float q0 = bf2f(qp[0]) * 0.125f, q1 = bf2f(qp[1]) * 0.125f, q2 = bf2f(qp[2]) * 0.125f, q3 = bf2f(qp[3]) * 0.125f;
    float m = sinks[hq], l = 1.f, o0 = 0.f, o1 = 0.f, o2 = 0.f, o3 = 0.f;
    const int pos = s + 16;
    const int lo = (pos - 127) > 16 ? (pos - 127) : 16;
    const int nband = pos - lo + 1;
    for (int t = 0; t < 16 + nband; ++t) {
        const int tp = t < 16 ? t : lo + (t - 16);
        const bf16_t* kp = ZP + (rowb + 112 + tp) * NIN + C_K + kvh * 64 + 4 * j;
        const bf16_t* vp = ZP + (rowb + 112 + tp) * NIN + C_V + kvh * 64 + 4 * j;
        float sc = q0 * bf2f(kp[0]) + q1 * bf2f(kp[1]) + q2 * bf2f(kp[2]) + q3 * bf2f(kp[3]);
        sc += __shfl_xor(sc, 1); sc += __shfl_xor(sc, 2); sc += __shfl_xor(sc, 4); sc += __shfl_xor(sc, 8);
        const float mn = fmaxf(m, sc), al = __expf(m - mn), pe = __expf(sc - mn);
        l = l * al + pe;
        o0 = o0 * al + pe * bf2f(vp[0]); o1 = o1 * al + pe * bf2f(vp[1]); o2 = o2 * al + pe * bf2f(vp[2]); o3 = o3 * al + pe * bf2f(vp[3]);
        m = mn;
    }
    const float il = 1.f / l;
    uint2* op = (uint2*)(AY + (size_t)r * 3072 + hq * 64 + 4 * j);
    *op = make_uint2(pk2(o0 * il, o1 * il), pk2(o2 * il, o3 * il));
}

__global__ void __launch_bounds__(256) k_ssd_naive(const bf16_t* __restrict__ ZP, const float* __restrict__ conv_w, const float* __restrict__ conv_b,
                                                   const float* __restrict__ dt_bias, const float* __restrict__ a_log, const float* __restrict__ d_skip,
                                                   float* __restrict__ YZ, float* __restrict__ SS) {
    const int wave = threadIdx.x >> 6, lane = threadIdx.x & 63;
    const int item = blockIdx.x * 4 + wave;
    const int p = item & 63, h = (item >> 6) & 31, b = item >> 11, g = h >> 3;
    const int chx = h * 64 + p, chB0 = 2048 + g * 128 + lane, chB1 = chB0 + 64, chC0 = 2560 + g * 128 + lane, chC1 = chC0 + 64;
    float wx[4], wB0[4], wB1[4], wC0[4], wC1[4];
#pragma unroll
    for (int i = 0; i < 4; ++i) { wx[i] = conv_w[i * 3072 + chx]; wB0[i] = conv_w[i * 3072 + chB0]; wB1[i] = conv_w[i * 3072 + chB1]; wC0[i] = conv_w[i * 3072 + chC0]; wC1[i] = conv_w[i * 3072 + chC1]; }
    const float bx = conv_b[chx], bB0 = conv_b[chB0], bB1 = conv_b[chB1], bC0 = conv_b[chC0], bC1 = conv_b[chC1];
    const float dtb = dt_bias[h], a = -__expf(a_log[h]), dsk = d_skip[h];
    float xr0 = 0, xr1 = 0, xr2 = 0, B0r0 = 0, B0r1 = 0, B0r2 = 0, B1r0 = 0, B1r1 = 0, B1r2 = 0, C0r0 = 0, C0r1 = 0, C0r2 = 0, C1r0 = 0, C1r1 = 0, C1r2 = 0;
    float st0 = 0.f, st1 = 0.f;
    const bf16_t* base = ZP + ((size_t)b * LP + 112) * NIN;
    for (int t = 0; t < SEQ + NMETA; ++t) {
        const bf16_t* row = base + (size_t)t * NIN;
        const float xn = bf2f(row[C_X + chx]), B0n = bf2f(row[C_X + chB0]), B1n = bf2f(row[C_X + chB1]), C0n = bf2f(row[C_X + chC0]), C1n = bf2f(row[C_X + chC1]);
        const float dtr = bf2f(row[C_DT + h]) + dtb;
        const float xc = siluf(wx[0] * xr0 + wx[1] * xr1 + wx[2] * xr2 + wx[3] * xn + bx);
        const float Bc0 = siluf(wB0[0] * B0r0 + wB0[1] * B0r1 + wB0[2] * B0r2 + wB0[3] * B0n + bB0);
        const float Bc1 = siluf(wB1[0] * B1r0 + wB1[1] * B1r1 + wB1[2] * B1r2 + wB1[3] * B1n + bB1);
        const float Cc0 = siluf(wC0[0] * C0r0 + wC0[1] * C0r1 + wC0[2] * C0r2 + wC0[3] * C0n + bC0);
        const float Cc1 = siluf(wC1[0] * C1r0 + wC1[1] * C1r1 + wC1[2] * C1r2 + wC1[3] * C1n + bC1);
        xr0 = xr1; xr1 = xr2; xr2 = xn; B0r0 = B0r1; B0r1 = B0r2; B0r2 = B0n; B1r0 = B1r1; B1r1 = B1r2; B1r2 = B1n;
        C0r0 = C0r1; C0r1 = C0r2; C0r2 = C0n; C1r0 = C1r1; C1r1 = C1r2; C1r2 = C1n;
        const float dt = dtr > 20.f ? dtr : log1pf(__expf(dtr));
        const float dA = __expf(dt * a), dx = dt * xc;
        st0 = st0 * dA + dx * Bc0; st1 = st1 * dA + dx * Bc1;
        float y = wave_sum(Cc0 * st0 + Cc1 * st1) + dsk * xc;
        if (t >= NMETA) {
            const int r = b * SEQ + t - NMETA;
            const float z = bf2f(row[C_Z + chx]);
            const float yz = y * siluf(z);
            if (lane == 0) { YZ[(size_t)r * DM + chx] = yz; atomicAdd(&SS[r * 4 + g], yz * yz); }
        }
    }
}
__global__ void __launch_bounds__(256) k_ssd_norm(const float* __restrict__ YZ, const float* __restrict__ SS, const float* __restrict__ ng, bf16_t* __restrict__ AY) {
    const size_t idx = (size_t)blockIdx.x * 256 + threadIdx.x;
    const int r = (int)(idx >> 11), ch = (int)(idx & 2047), g = ch >> 9;
    const float v = YZ[idx] * (1.f / sqrtf(SS[r * 4 + g] * (1.f / 512.f) + RMS_EPS)) * ng[ch];
    AY[(size_t)r * 3072 + 1024 + ch] = f2bf(v);
}

__global__ void __launch_bounds__(256) k_ln1_router(const float* __restrict__ U, const float* __restrict__ g1, const float* __restrict__ b1,
                                                    const float* __restrict__ wrg, const float* __restrict__ brg, const float* __restrict__ wre, const float* __restrict__ bre,
                                                    float* __restrict__ H1, bf16_t* __restrict__ H1B, int* __restrict__ cnt, int* __restrict__ list_ent, float* __restrict__ list_w) {
    const int wave = threadIdx.x >> 6, lane = threadIdx.x & 63;
    const int r = blockIdx.x * 4 + wave; if (r >= MR) return;
    const float4* up = (const float4*)(U + (size_t)r * DM);
    float4 v[8]; float s = 0.f;
#pragma unroll
    for (int j = 0; j < 8; ++j) { v[j] = up[lane + 64 * j]; s += (v[j].x + v[j].y) + (v[j].z + v[j].w); }
    const float mean = wave_sum(s) * (1.f / DM); float q = 0.f;
#pragma unroll
    for (int j = 0; j < 8; ++j) { v[j].x -= mean; v[j].y -= mean; v[j].z -= mean; v[j].w -= mean; q += (v[j].x * v[j].x + v[j].y * v[j].y) + (v[j].z * v[j].z + v[j].w * v[j].w); }
    const float rstd = 1.f / sqrtf(wave_sum(q) * (1.f / DM) + LN_EPS);
    float4* hp = (float4*)(H1 + (size_t)r * DM); uint2* hb = (uint2*)(H1B + (size_t)r * DM);
#pragma unroll
    for (int j = 0; j < 8; ++j) {
        const float4 gg = ((const float4*)g1)[lane + 64 * j], bb = ((const float4*)b1)[lane + 64 * j];
        v[j].x = v[j].x * rstd * gg.x + bb.x; v[j].y = v[j].y * rstd * gg.y + bb.y; v[j].z = v[j].z * rstd * gg.z + bb.z; v[j].w = v[j].w * rstd * gg.w + bb.w;
        hp[lane + 64 * j] = v[j]; hb[lane + 64 * j] = make_uint2(pk2(v[j].x, v[j].y), pk2(v[j].z, v[j].w));
    }
    float lg[8], le[64];
#pragma unroll
    for (int c = 0; c < 8; ++c) lg[c] = 0.f;
#pragma unroll
    for (int c = 0; c < 64; ++c) le[c] = 0.f;
#pragma unroll
    for (int j = 0; j < 8; ++j) {
        const int i0 = (lane + 64 * j) * 4;
        const float hv[4] = {v[j].x, v[j].y, v[j].z, v[j].w};
#pragma unroll
        for (int qq = 0; qq < 4; ++qq) {
            const float4* wg = (const float4*)(wrg + (size_t)(i0 + qq) * 8);
            const float4 w0 = wg[0], w1 = wg[1];
            lg[0] += hv[qq] * w0.x; lg[1] += hv[qq] * w0.y; lg[2] += hv[qq] * w0.z; lg[3] += hv[qq] * w0.w;
            lg[4] += hv[qq] * w1.x; lg[5] += hv[qq] * w1.y; lg[6] += hv[qq] * w1.z; lg[7] += hv[qq] * w1.w;
            const float4* we = (const float4*)(wre + (size_t)(i0 + qq) * 64);
#pragma unroll
            for (int c = 0; c < 16; ++c) { const float4 w = we[c]; le[4 * c] += hv[qq] * w.x; le[4 * c + 1] += hv[qq] * w.y; le[4 * c + 2] += hv[qq] * w.z; le[4 * c + 3] += hv[qq] * w.w; }
        }
    }
#pragma unroll
    for (int c = 0; c < 8; ++c) lg[c] = wave_sum(lg[c]) + brg[c];
#pragma unroll
    for (int c = 0; c < 64; ++c) le[c] = wave_sum(le[c]) + bre[c];
    int gi = 0; float gm = lg[0];
#pragma unroll
    for (int c = 1; c < 8; ++c) if (lg[c] > gm) { gm = lg[c]; gi = c; }
    float den = 0.f;
#pragma unroll
    for (int c = 0; c < 8; ++c) den += __expf(lg[c] - gm);
    const float ptop = 1.f / den;
    float sel[8];
#pragma unroll
    for (int jj = 0; jj < 8; ++jj) sel[jj] = le[jj];
#pragma unroll
    for (int gg = 1; gg < 8; ++gg)
#pragma unroll
        for (int jj = 0; jj < 8; ++jj) sel[jj] = (gi == gg) ? le[gg * 8 + jj] : sel[jj];
    int i1 = 0; float m1 = sel[0];
#pragma unroll
    for (int jj = 1; jj < 8; ++jj) if (sel[jj] > m1) { m1 = sel[jj]; i1 = jj; }
    int i2 = -1; float m2 = -3.0e38f;
#pragma unroll
    for (int jj = 0; jj < 8; ++jj) if (jj != i1 && sel[jj] > m2) { m2 = sel[jj]; i2 = jj; }
    const float e2 = __expf(m2 - m1), w1 = ptop / (1.f + e2), w2 = ptop * e2 / (1.f + e2);
    if (lane == 0) {
        const int ea = gi * 8 + i1, eb = gi * 8 + i2;
        const int pa = atomicAdd(&cnt[ea], 1); list_ent[ea * MR + pa] = r * 2; list_w[ea * MR + pa] = w1;
        const int pb = atomicAdd(&cnt[eb], 1); list_ent[eb * MR + pb] = r * 2 + 1; list_w[eb * MR + pb] = w2;
    }
}

__global__ void __launch_bounds__(256) k_moe_plan(const int* __restrict__ cnt, const int* __restrict__ list_ent, const float* __restrict__ list_w,
                                                  int* __restrict__ tile_e, int* __restrict__ pos_ent, int* __restrict__ pos_src, float* __restrict__ pos_w) {
    const int e = blockIdx.x;
    int tstart = 0, total = 0;
    for (int i = 0; i < NE; ++i) { const int nt = (cnt[i] + MOE_TILE - 1) / MOE_TILE; if (i < e) tstart += nt; total += nt; }
    const int c = cnt[e], nt = (c + MOE_TILE - 1) / MOE_TILE;
    for (int t = threadIdx.x; t < nt; t += 256) tile_e[tstart + t] = e;
    if (e == NE - 1) for (int t = total + threadIdx.x; t < MOE_MAXT; t += 256) tile_e[t] = -1;
    for (int i = threadIdx.x; i < nt * MOE_TILE; i += 256) {
        const int pos = tstart * MOE_TILE + i;
        if (i < c) { const int ent = list_ent[e * MR + i]; pos_ent[pos] = ent; pos_src[pos] = ent >> 1; pos_w[pos] = list_w[e * MR + i]; }
        else { pos_ent[pos] = -1; pos_src[pos] = 0; pos_w[pos] = 0.f; }
    }
}
__global__ void __launch_bounds__(256) k_silu_mul(const bf16_t* __restrict__ GU, const int* __restrict__ tile_e, bf16_t* __restrict__ HID) {
    const size_t idx = (size_t)blockIdx.x * 256 + threadIdx.x;
    const int pos = (int)(idx >> 9), c = (int)(idx & 511);
    if (tile_e[pos >> 8] < 0) return;
    const int pn = c >> 7, j = c & 127;
    const float gt = bf2f(GU[(size_t)pos * 1024 + pn * 256 + j]), up = bf2f(GU[(size_t)pos * 1024 + pn * 256 + 128 + j]);
    HID[(size_t)pos * 512 + c] = f2bf(siluf(gt) * up);
}

__global__ void __launch_bounds__(256) k_ln2(const float* __restrict__ H1, const bf16_t* __restrict__ Y, const float* __restrict__ g2, const float* __restrict__ b2, float* __restrict__ out) {
    const int wave = threadIdx.x >> 6, lane = threadIdx.x & 63;
    const int r = blockIdx.x * 4 + wave; if (r >= MR) return;
    const float4* hp = (const float4*)(H1 + (size_t)r * DM);
    const uint2* y0 = (const uint2*)(Y + (size_t)(2 * r) * DM); const uint2* y1 = (const uint2*)(Y + (size_t)(2 * r + 1) * DM);
    float4 v[8]; float s = 0.f;
#pragma unroll
    for (int j = 0; j < 8; ++j) {
        const float4 h = hp[lane + 64 * j]; const uint2 a = y0[lane + 64 * j], c = y1[lane + 64 * j];
        v[j].x = ALPHA * h.x + __uint_as_float(a.x << 16) + __uint_as_float(c.x << 16);
        v[j].y = ALPHA * h.y + __uint_as_float(a.x & 0xffff0000u) + __uint_as_float(c.x & 0xffff0000u);
        v[j].z = ALPHA * h.z + __uint_as_float(a.y << 16) + __uint_as_float(c.y << 16);
        v[j].w = ALPHA * h.w + __uint_as_float(a.y & 0xffff0000u) + __uint_as_float(c.y & 0xffff0000u);
        s += (v[j].x + v[j].y) + (v[j].z + v[j].w);
    }
    const float mean = wave_sum(s) * (1.f / DM); float q = 0.f;
#pragma unroll
    for (int j = 0; j < 8; ++j) { v[j].x -= mean; v[j].y -= mean; v[j].z -= mean; v[j].w -= mean; q += (v[j].x * v[j].x + v[j].y * v[j].y) + (v[j].z * v[j].z + v[j].w * v[j].w); }
    const float rstd = 1.f / sqrtf(wave_sum(q) * (1.f / DM) + LN_EPS);
    float4* op = (float4*)(out + (size_t)r * DM);
#pragma unroll
    for (int j = 0; j < 8; ++j) {
        const float4 gg = ((const float4*)g2)[lane + 64 * j], bb = ((const float4*)b2)[lane + 64 * j];
        op[lane + 64 * j] = make_float4(v[j].x * rstd * gg.x + bb.x, v[j].y * rstd * gg.y + bb.y, v[j].z * rstd * gg.z + bb.z, v[j].w * rstd * gg.w + bb.w);
    }
}

extern "C" void kernel_launch(void* const* d_in, const int* in_sizes, int n_in, void* d_out, int out_size, void* d_ws, size_t ws_size, hipStream_t stream) {
    if (n_in != 26 || ws_size < WS_END) { fprintf(stderr, "kernel_launch: unexpected n_in %d or ws_size %zu\n", n_in, ws_size); return; }
    const float* x = (const float*)d_in[0]; const float* meta = (const float*)d_in[1]; const float* ln0g = (const float*)d_in[2]; const float* ln0b = (const float*)d_in[3];
    const float* w_in = (const float*)d_in[4]; const float* conv_w = (const float*)d_in[5]; const float* conv_b = (const float*)d_in[6];
    const float* dt_bias = (const float*)d_in[7]; const float* a_log = (const float*)d_in[8]; const float* d_skip = (const float*)d_in[9];
    const float* norm_g = (const float*)d_in[10]; const float* sinks = (const float*)d_in[11];
    const float* w_bra = (const float*)d_in[12]; const float* w_brs = (const float*)d_in[13]; const float* w_o = (const float*)d_in[14];
    const float* ln1g = (const float*)d_in[15]; const float* ln1b = (const float*)d_in[16];
    const float* wrg = (const float*)d_in[17]; const float* brg = (const float*)d_in[18]; const float* wre = (const float*)d_in[19]; const float* bre = (const float*)d_in[20];
    const float* w_gate = (const float*)d_in[21]; const float* w_up = (const float*)d_in[22]; const float* w_down = (const float*)d_in[23];
    const float* ln2g = (const float*)d_in[24]; const float* ln2b = (const float*)d_in[25];
    float* out = (float*)d_out; char* ws = (char*)d_ws;
    int* cnt = (int*)(ws + OFF_CNT); float* SS = (float*)(ws + OFF_SS); float* rowstat = (float*)(ws + OFF_ROWSTAT); int* tile_e = (int*)(ws + OFF_TILE_E);
    bf16_t* WIN = (bf16_t*)(ws + WS_WIN); bf16_t* WBRA = (bf16_t*)(ws + WS_WBRA); bf16_t* WBRS = (bf16_t*)(ws + WS_WBRS); bf16_t* WO = (bf16_t*)(ws + WS_WO);
    bf16_t* WGU = (bf16_t*)(ws + WS_WGU); bf16_t* WDN = (bf16_t*)(ws + WS_WDN);
    bf16_t* H0 = (bf16_t*)(ws + WS_H0); bf16_t* T1S = (bf16_t*)(ws + WS_T1S); bf16_t* ZP = (bf16_t*)(ws + WS_ZP);
    float* U = (float*)(ws + WS_U); bf16_t* GU = (bf16_t*)(ws + WS_GU); float* H1 = (float*)(ws + WS_H1); bf16_t* H1B = (bf16_t*)(ws + WS_H1B);
    int* list_ent = (int*)(ws + WS_LIST); float* list_w = (float*)(ws + WS_LISTW);
    int* pos_ent = (int*)(ws + WS_POS); int* pos_src = pos_ent + MOE_MAXPOS; float* pos_w = (float*)(pos_src + MOE_MAXPOS);
    bf16_t* HID = (bf16_t*)(ws + WS_HID); bf16_t* AY = (bf16_t*)(ws + WS_AY); bf16_t* MG = (bf16_t*)(ws + WS_MERGED); bf16_t* Y = (bf16_t*)(ws + WS_Y);

    hipMemsetAsync(ws + WS_CTL, 0, CTL_BYTES, stream);
    k_transpose<<<dim3(DM / 32, NIN / 32, 1), 256, 0, stream>>>(w_in, nullptr, 10784, 0, WIN, DM, 0, 1);
    k_transpose<<<dim3(1024 / 32, DM / 32, 1), 256, 0, stream>>>(w_bra, nullptr, DM, 0, WBRA, 1024, 0, 0);
    k_transpose<<<dim3(DM / 32, DM / 32, 1), 256, 0, stream>>>(w_brs, nullptr, DM, 0, WBRS, DM, 0, 0);
    k_transpose<<<dim3(DM / 32, DM / 32, 1), 256, 0, stream>>>(w_o, nullptr, DM, 0, WO, DM, 0, 0);
    k_transpose<<<dim3(DM / 32, 1024 / 32, NE), 256, 0, stream>>>(w_gate, w_up, DE, (size_t)DM * DE, WGU, DM, (size_t)1024 * DM, 2);
    k_transpose<<<dim3(DE / 32, DM / 32, NE), 256, 0, stream>>>(w_down, nullptr, DM, (size_t)DE * DM, WDN, DE, (size_t)DM * DE, 0);
    k_ln0<<<MP / 4, 256, 0, stream>>>(x, meta, ln0g, ln0b, H0, rowstat);
    k_gemm<EpiStoreBf16><<<dim3(NIN / 128, MP / 128), 256, 0, stream>>>(H0, DM, nullptr, WIN, DM, DM, nullptr, 0, EpiStoreBf16{ZP, (size_t)NIN});
    k_attn_naive<<<MR * HKV / 4, 256, 0, stream>>>(ZP, sinks, AY);
    k_ssd_naive<<<BATCH * SH * SP / 4, 256, 0, stream>>>(ZP, conv_w, conv_b, dt_bias, a_log, d_skip, out  , SS);
    k_ssd_norm<<<MR * DM / 256, 256, 0, stream>>>(out, SS, norm_g, AY);
    k_gemm<EpiBrA><<<dim3(DM / 128, MR / 128), 256, 0, stream>>>(AY, 3072, nullptr, WBRA, 1024, 1024, nullptr, 0, EpiBrA{T1S, ZP});
    k_gemm<EpiBrS><<<dim3(DM / 128, MR / 128), 256, 0, stream>>>(AY + 1024, 3072, nullptr, WBRS, DM, DM, nullptr, 0, EpiBrS{T1S, ZP, MG});
    k_gemm<EpiWo><<<dim3(DM / 128, MR / 128), 256, 0, stream>>>(MG, DM, nullptr, WO, DM, DM, nullptr, 0, EpiWo{U, x, rowstat, ln0g, ln0b});
    k_ln1_router<<<MR / 4, 256, 0, stream>>>(U, ln1g, ln1b, wrg, brg, wre, bre, H1, H1B, cnt, list_ent, list_w);
    k_moe_plan<<<NE, 256, 0, stream>>>(cnt, list_ent, list_w, tile_e, pos_ent, pos_src, pos_w);
    k_gemm<EpiStoreBf16><<<dim3(1024 / 128, MOE_MAXT * 2), 256, 0, stream>>>(H1B, DM, pos_src, WGU, DM, DM, tile_e, (size_t)1024 * DM, EpiStoreBf16{GU, (size_t)1024});
    k_silu_mul<<<MOE_MAXPOS * 512 / 256, 256, 0, stream>>>(GU, tile_e, HID);
    k_gemm<EpiDown><<<dim3(DM / 128, MOE_MAXT * 2), 256, 0, stream>>>(HID, DE, nullptr, WDN, DE, DE, tile_e, (size_t)DM * DE, EpiDown{Y, pos_ent, pos_w});
    k_ln2<<<MR / 4, 256, 0, stream>>>(H1, Y, ln2g, ln2b, out);
}
```

```cpp
#include <hip/hip_runtime.h>
#include <stdint.h>
#include <stdio.h>

typedef unsigned short bf16_t;
typedef short bf16x8 __attribute__((ext_vector_type(8)));
typedef float f32x16 __attribute__((ext_vector_type(16)));
#define DEVINL __device__ __forceinline__
#define LAS __attribute__((address_space(3)))
#define WGM_INPROJ 4
#define WGM_DENSE 2
#define MOE_WF32 1
#define WF32_ROWMAP_GU 1
#define WF32_ROWMAP_DN 1
#define PROBE_P8_TWICE 0
#define REPEAT_MASK 0
#define EXTRA_BARRIERS 0
#ifndef MK_PER_PHASE
#define MK_PER_PHASE 0
#endif

constexpr int BATCH = 2, SEQ = 8192, DM = 2048, NMETA = 16;
constexpr int LP = 8320;
constexpr int MP = BATCH * LP;
constexpr int MR = BATCH * SEQ;
constexpr int NIN = 11008;
constexpr int C_Q = 0, C_K = 1024, C_V = 1280, C_Z = 1536, C_X = 3584, C_B = 5632, C_C = 6144, C_GA = 6656, C_GS = 8704, C_DT = 10752;
constexpr int HQ = 16, HKV = 4, HD = 64;
constexpr int SH = 32, SP = 64, SG = 4, SN = 128;
constexpr int NE = 64, DE = 512;
constexpr int MOE_TILE = 256, MOE_MAXT = 192, MOE_MAXPOS = MOE_MAXT * MOE_TILE;
constexpr float LN_EPS = 1e-5f, RMS_EPS = 1e-5f;
constexpr float ALPHA = 1.189207115002721f;

constexpr size_t MiB = 1ull << 20;
constexpr size_t WS_CTL = 0;
constexpr size_t CTL_BYTES = 1 * MiB;
constexpr size_t OFF_CNT = 64 * 1024;
constexpr size_t OFF_SS = 128 * 1024;
constexpr size_t WS_MISC = 1 * MiB;
constexpr size_t OFF_ROWSTAT = WS_MISC;
constexpr size_t OFF_ROWSTAT1 = WS_MISC + 128 * 1024;
constexpr size_t OFF_TILE_E = WS_MISC + 256 * 1024;
constexpr size_t OFF_WREG = WS_MISC + 512 * 1024;
constexpr size_t OFF_NT = WS_MISC + 260 * 1024;
constexpr size_t OFF_CD = WS_MISC + 264 * 1024;
constexpr size_t WS_WIN = 2 * MiB;
constexpr size_t WS_WBRA = 45 * MiB;
constexpr size_t WS_WBRS = 49 * MiB;
constexpr size_t WS_WO = 57 * MiB;
constexpr size_t WS_WGU = 65 * MiB;
constexpr size_t WS_WDN = 321 * MiB;
constexpr size_t WS_XCT = 65 * MiB;
constexpr size_t WS_BCC = 130 * MiB;
constexpr size_t WS_CCC = 147 * MiB;
constexpr size_t WS_BTT = 164 * MiB;
constexpr size_t WS_H0 = 449 * MiB;
constexpr size_t WS_T1S = 449 * MiB;
constexpr size_t WS_SST = 449 * MiB;
constexpr size_t WS_PREV = 960 * MiB;
constexpr size_t WS_ZP = 514 * MiB;
constexpr size_t WS_U = 514 * MiB;
constexpr size_t WS_H1 = 642 * MiB;
constexpr size_t WS_H1B = 770 * MiB;
constexpr size_t WS_LIST = 834 * MiB;
constexpr size_t WS_LISTW = 838 * MiB;
constexpr size_t WS_POS = 842 * MiB;
constexpr size_t WS_HID = 844 * MiB;
constexpr size_t WS_AY = 864 * MiB;
constexpr size_t WS_MERGED = 960 * MiB;
constexpr size_t WS_Y = 892 * MiB;
constexpr size_t WS_END = 1024 * MiB;

DEVINL float bf2f(bf16_t h) { return __uint_as_float(((unsigned)h) << 16); }
typedef __bf16 bf16x2_t __attribute__((ext_vector_type(2)));
typedef float f32x2_t __attribute__((ext_vector_type(2)));
DEVINL unsigned cvtpk(float lo, float hi) { f32x2_t v = {lo, hi}; bf16x2_t b = __builtin_convertvector(v, bf16x2_t); return __builtin_bit_cast(unsigned, b); }
DEVINL unsigned pk2(float lo, float hi) { return cvtpk(lo, hi); }
DEVINL bf16_t f2bf(float f) { return (bf16_t)(cvtpk(f, 0.f) & 0xffffu); }
DEVINL float bf_lo(unsigned w) { return __uint_as_float(w << 16); }
DEVINL float bf_hi(unsigned w) { return __uint_as_float(w & 0xffff0000u); }
DEVINL float wave_sum(float v) {
#pragma unroll
    for (int o = 1; o < 64; o <<= 1) v += __shfl_xor(v, o);
    return v;
}
DEVINL float sigmoidf(float x) { return __builtin_amdgcn_rcpf(1.f + __builtin_amdgcn_exp2f(-1.4426950408889634f * x)); }
DEVINL float siluf(float x) { return x * __builtin_amdgcn_rcpf(1.f + __builtin_amdgcn_exp2f(-1.4426950408889634f * x)); }
DEVINL int prow_of(int r) { return (r >> 13) * LP + 128 + (r & (SEQ - 1)); }
#define LDS_WAIT() asm volatile("s_waitcnt lgkmcnt(0)" ::: "memory")

namespace pg8 {
#define PG8_LAS __attribute__((address_space(3)))
typedef float f32x4 __attribute__((ext_vector_type(4)));
typedef unsigned u32x4 __attribute__((ext_vector_type(4)));
typedef unsigned u32x2 __attribute__((ext_vector_type(2)));
constexpr int BM = 256, BK = 64, HALF = 128, HTB = HALF * BK * 2, STAGE_BYTES = 8 * HTB, NXCD = 8, WGM = 8;
__host__ __device__ __forceinline__ int lds_byte(int r, int c) { const int st = (r >> 4) * 2 + (c >> 5), rr = r & 15, cc = c & 31, ob = rr * 64 + cc * 2; return st * 1024 + (ob ^ (((ob >> 9) & 1) << 5)); }
__host__ __device__ __forceinline__ void stage_rc(int b, int& R, int& C) { const int st = b / 1024, sb = b % 1024, swz = sb ^ (((sb >> 9) & 1) << 5); R = (st >> 1) * 16 + swz / 64; C = (st & 1) * 32 + (swz % 64) / 2; }
__host__ __device__ __forceinline__ int perm32(int rho) { const int n = rho >> 4, i = rho & 15; return 8 * (i >> 2) + 4 * n + (i & 3); }
struct Unit { int pm, pn; };
struct Gemm { const bf16_t* A; const bf16_t* Bt; int lda, ldb, K; };

struct StaticOrder {
    int nM, nN, nwg, G, c, wgm; const bf16_t* A; const bf16_t* Bt; int lda, ldb;
    __device__ void init(const Gemm& g, int M, int N, int G_, int c_, int wgm_ = WGM) { nM = M / BM; nN = N / BM; nwg = nM * nN; G = G_; c = c_; wgm = wgm_; A = g.A; Bt = g.Bt; lda = g.lda; ldb = g.ldb; }
    __device__ bool next(int i, Unit& u) const {
        const long L = (long)i * G + c; if (L >= nwg) return false;
        int wgid = (int)L; { const int q = nwg / NXCD, r = nwg % NXCD, xcd = wgid % NXCD, off = wgid / NXCD; wgid = (xcd < r ? xcd * (q + 1) : r * (q + 1) + (xcd - r) * q) + off; }
        const int nig = wgm * nN, gid = wgid / nig, fm = gid * wgm, gsz = (nM - fm) < wgm ? (nM - fm) : wgm;
        u.pm = fm + ((wgid % nig) % gsz); u.pn = (wgid % nig) / gsz; return true;
    }
    __device__ __forceinline__ const char* a_base(const Unit& u) const { return (const char*)(A + (size_t)u.pm * BM * lda); }
    __device__ __forceinline__ const char* b_base(const Unit& u) const { return (const char*)(Bt + (size_t)u.pn * BM * ldb); }
    __device__ __forceinline__ int a_row(const Unit&, int r) const { return r; }
    __device__ __forceinline__ bool half(const Unit&) const { return false; }
};
__device__ __forceinline__ unsigned cvt_pk_bf16(float lo, float hi) { unsigned r; asm volatile("v_cvt_pk_bf16_f32 %0, %1, %2" : "=v"(r) : "v"(lo), "v"(hi)); return r; }

template <class Epi, class Sched, bool ALIGN_EPI, bool GATHER>
__device__ __forceinline__ void gemm_phase(PG8_LAS unsigned char* lds, const Gemm g, const Sched& S, const Epi& E) {
    const int tid = threadIdx.x, wid = __builtin_amdgcn_readfirstlane(tid >> 6), lane = tid & 63, wr = wid >> 2, wc = wid & 3, fr = lane & 15, fq = lane >> 4;
    const int K = g.K, nt = K / BK;
    unsigned voffA[2][2], voffB[2]; int RA[2], CA[2];
#pragma unroll
    for (int i = 0; i < 2; ++i) { int R, C; stage_rc(tid * 16 + i * 8192, R, C); const int Rb = Epi::PERM ? ((R & ~31) + perm32(R & 31)) : R;
        RA[i] = R; CA[i] = C; voffA[0][i] = (unsigned)(R * g.lda + C) * 2u; voffA[1][i] = (unsigned)((R + HALF) * g.lda + C) * 2u; voffB[i] = (unsigned)(Rb * g.ldb + C) * 2u; }
    const size_t kstep = (size_t)(BK * 2);
    const size_t hstepB = (size_t)HALF * g.ldb * 2;
    const unsigned ldsw = (unsigned)wid * 1024u;
    const int aoff = lds_byte(wr * 64 + fr, fq * 8), boff = lds_byte(wc * 32 + fr, fq * 8);
#define PG8_SA(b, h) (((b) * 2 + (h)) * HTB)
#define PG8_SB(b, h) ((4 + (b) * 2 + (h)) * HTB)
#define PG8_STAGE(bufoff, gbase, voff) do { _Pragma("unroll") for (int _i = 0; _i < 2; ++_i) \
        __builtin_amdgcn_global_load_lds((const unsigned*)((const char*)(gbase) + (voff)[_i]), (PG8_LAS unsigned*)(lds + (bufoff) + ldsw + _i * 8192), 16, 0, 0); } while (0)
#define PG8_LDA(dst, b, h) do { _Pragma("unroll") for (int m = 0; m < 4; ++m) _Pragma("unroll") for (int k = 0; k < 2; ++k) dst[m][k] = *(const PG8_LAS bf16x8*)(lds + PG8_SA(b, h) + aoff + m * 2048 + k * 1024); } while (0)
#define PG8_LDB(dst, b, h) do { _Pragma("unroll") for (int n = 0; n < 2; ++n) _Pragma("unroll") for (int k = 0; k < 2; ++k) dst[n][k] = *(const PG8_LAS bf16x8*)(lds + PG8_SB(b, h) + boff + n * 2048 + k * 1024); } while (0)
#define PG8_MMA(ai, bj, At, Bt) do { __builtin_amdgcn_s_setprio(1); _Pragma("unroll") for (int m = 0; m < 4; ++m) _Pragma("unroll") for (int n = 0; n < 2; ++n) _Pragma("unroll") for (int k = 0; k < 2; ++k) \
        acc[ai][bj][m][n] = __builtin_amdgcn_mfma_f32_16x16x32_bf16(Bt[n][k], At[m][k], acc[ai][bj][m][n], 0, 0, 0); __builtin_amdgcn_s_setprio(0); } while (0)
#define PG8_WAIT_V(n) asm volatile("s_waitcnt vmcnt(" #n ")" ::: "memory")
#define PG8_WAIT_L(n) asm volatile("s_waitcnt lgkmcnt(" #n ")" ::: "memory")
#define PG8_BAR __builtin_amdgcn_s_barrier()
#define PG8_SCHED __builtin_amdgcn_sched_barrier(0)
#define PG8_GVOFF(u, vo) do { if constexpr (GATHER) { _Pragma("unroll") for (int _h = 0; _h < 2; ++_h) _Pragma("unroll") for (int _i = 0; _i < 2; ++_i) \
        vo[_h][_i] = (unsigned)(S.a_row(u, _h * HALF + RA[_i]) * g.lda + CA[_i]) * 2u; } } while (0)
    Unit cur, nxt; int ui = 0;
    if (!S.next(0, cur)) return;
    f32x4 acc[2][2][4][2];
#pragma unroll
    for (int a = 0; a < 2; ++a)
#pragma unroll
        for (int b = 0; b < 2; ++b)
#pragma unroll
            for (int m = 0; m < 4; ++m)
#pragma unroll
                for (int n = 0; n < 2; ++n) acc[a][b][m][n] = (f32x4){0.f, 0.f, 0.f, 0.f};
    bf16x8 At[4][2], B0[2][2], B1[2][2];
    unsigned nvoffA[2][2];
    PG8_GVOFF(cur, voffA);
    const char* cA = S.a_base(cur); const char* cB = S.b_base(cur);
    PG8_STAGE(PG8_SB(0, 0), cB, voffB); PG8_STAGE(PG8_SB(0, 1), cB + hstepB, voffB); PG8_STAGE(PG8_SA(0, 0), cA, voffA[0]); PG8_STAGE(PG8_SA(0, 1), cA, voffA[1]);
    if (wr == 1) PG8_BAR;
    PG8_WAIT_V(2); PG8_BAR;
    PG8_STAGE(PG8_SB(1, 0), cB + kstep, voffB); PG8_STAGE(PG8_SA(1, 0), cA + kstep, voffA[0]); PG8_STAGE(PG8_SB(1, 1), cB + hstepB + kstep, voffB);
    PG8_WAIT_V(6); PG8_BAR;
    for (;;) {
        const bool has_next = S.next(ui + 1, nxt);
        const bool hf = S.half(cur);
        const char* nA = has_next ? S.a_base(nxt) : cA; const char* nB = has_next ? S.b_base(nxt) : cB;
        if constexpr (GATHER) { if (has_next) { PG8_GVOFF(nxt, nvoffA); } else {
#pragma unroll
            for (int _h = 0; _h < 2; ++_h)
#pragma unroll
                for (int _i = 0; _i < 2; ++_i) nvoffA[_h][_i] = voffA[_h][_i]; } }
        for (int t = 0; t < nt; t += 2) {
            const bool last = (t == nt - 2);
            const char* a1 = cA + (size_t)(t + 1) * kstep;
            const char* a2 = last ? nA : cA + (size_t)(t + 2) * kstep; const char* b2 = last ? nB : cB + (size_t)(t + 2) * kstep;
            const char* a3 = a2 + kstep; const char* b3 = b2 + kstep;
            unsigned va0[2], va1[2];
            if constexpr (GATHER) { va0[0] = last ? nvoffA[0][0] : voffA[0][0]; va0[1] = last ? nvoffA[0][1] : voffA[0][1]; va1[0] = last ? nvoffA[1][0] : voffA[1][0]; va1[1] = last ? nvoffA[1][1] : voffA[1][1]; }
            else { va0[0] = voffA[0][0]; va0[1] = voffA[0][1]; va1[0] = voffA[1][0]; va1[1] = voffA[1][1]; }
            PG8_LDB(B0, 0, 0); PG8_LDB(B1, 0, 1); PG8_SCHED; PG8_LDA(At, 0, 0); PG8_STAGE(PG8_SA(1, 1), a1, voffA[1]);
            PG8_WAIT_V(8); PG8_WAIT_L(0); PG8_BAR; PG8_MMA(0, 0, At, B0); PG8_MMA(0, 1, At, B1); PG8_BAR; PG8_SCHED;
            PG8_LDA(At, 0, 1); PG8_STAGE(PG8_SB(0, 0), b2, voffB); PG8_STAGE(PG8_SB(0, 1), b2 + hstepB, voffB); PG8_STAGE(PG8_SA(0, 0), a2, va0);
            PG8_WAIT_V(8); PG8_WAIT_L(0); PG8_BAR; if (!hf) { PG8_MMA(1, 0, At, B0); PG8_MMA(1, 1, At, B1); } PG8_BAR; PG8_SCHED;
            PG8_LDB(B0, 1, 0); PG8_LDB(B1, 1, 1); PG8_SCHED; PG8_LDA(At, 1, 0); PG8_STAGE(PG8_SA(0, 1), a2, va1);
            PG8_WAIT_V(8); PG8_WAIT_L(0); PG8_BAR; PG8_MMA(0, 0, At, B0); PG8_MMA(0, 1, At, B1); PG8_BAR; PG8_SCHED;
            PG8_LDA(At, 1, 1); PG8_STAGE(PG8_SB(1, 0), b3, voffB); PG8_STAGE(PG8_SB(1, 1), b3 + hstepB, voffB); PG8_STAGE(PG8_SA(1, 0), a3, va0);
            PG8_WAIT_V(8); PG8_WAIT_L(0); PG8_BAR; if (!hf) { PG8_MMA(1, 0, At, B0); PG8_MMA(1, 1, At, B1); } PG8_BAR; PG8_SCHED;
        }
        if constexpr (ALIGN_EPI) { if (wr == 0) PG8_BAR; }
        E(acc, cur, wr, wc, fr, fq);
        if (!has_next) break;
#pragma unroll
        for (int a = 0; a < 2; ++a)
#pragma unroll
            for (int b = 0; b < 2; ++b)
#pragma unroll
                for (int m = 0; m < 4; ++m)
#pragma unroll
                    for (int n = 0; n < 2; ++n) acc[a][b][m][n] = (f32x4){0.f, 0.f, 0.f, 0.f};
        cur = nxt; cA = nA; cB = nB; ++ui;
        if constexpr (GATHER) {
#pragma unroll
            for (int _h = 0; _h < 2; ++_h)
#pragma unroll
                for (int _i = 0; _i < 2; ++_i) voffA[_h][_i] = nvoffA[_h][_i]; }
        if constexpr (ALIGN_EPI) { if (wr == 1) PG8_BAR; }
    }
    PG8_WAIT_V(0);
    if constexpr (!ALIGN_EPI) { if (wr == 0) PG8_BAR; }
    PG8_BAR;
#undef PG8_SA
#undef PG8_SB
#undef PG8_STAGE
#undef PG8_LDA
#undef PG8_LDB
#undef PG8_MMA
#undef PG8_WAIT_V
#undef PG8_WAIT_L
#undef PG8_BAR
#undef PG8_SCHED
#undef PG8_GVOFF
}
#define PG8_GAS __attribute__((address_space(1)))
typedef const PG8_GAS char* gptr;
__device__ __forceinline__ gptr uniform_ptr(const char* p) { const unsigned long long v = (unsigned long long)p; const unsigned lo = __builtin_amdgcn_readfirstlane((unsigned)v), hi = __builtin_amdgcn_readfirstlane((unsigned)(v >> 32)); return (gptr)(((unsigned long long)hi << 32) | lo); }
struct WF32 { const float* W0; const float* W1; size_t estride; int pn_step; int ldw; };
typedef float f32x2 __attribute__((ext_vector_type(2)));
template <class Epi, class Sched, bool GATHER, int ROWMAP>
__device__ __forceinline__ void gemm_phase_wf32(PG8_LAS unsigned char* lds, const Gemm g, const Sched& S, const Epi& E, const WF32 wf) {
    static_assert(Epi::PERM, "the B staging map below is the PERM one");
    const int tid = threadIdx.x, wid = __builtin_amdgcn_readfirstlane(tid >> 6), lane = tid & 63, wr = wid >> 2, wc = wid & 3, fr = lane & 15, fq = lane >> 4;
    const int K = g.K, nt = K / BK;
    unsigned voffA[2][2]; int RA[2], CA[2];
#pragma unroll
    for (int i = 0; i < 2; ++i) { int R, C; stage_rc(tid * 16 + i * 8192, R, C); RA[i] = R; CA[i] = C; voffA[0][i] = (unsigned)(R * g.lda + C) * 2u; voffA[1][i] = (unsigned)((R + HALF) * g.lda + C) * 2u; }
    const size_t kstep = (size_t)(BK * 2);
    const unsigned ldsw = (unsigned)wid * 1024u, ldsb = (unsigned)(size_t)lds;
    const int aoff = lds_byte(wr * 64 + fr, fq * 8);
    const int bn_o = 2 * ((wid & 3) * 16 + (lane >> 2)), bc_o = bn_o & 31, bR_o = (bn_o & ~31) + 16 * ((bc_o >> 2) & 1) + 4 * (bc_o >> 3) + (bc_o & 3), bk_o = 32 * (wid >> 2) + 8 * (lane & 3);
    const int bn2 = 2 * lane, bc2 = bn2 & 31, bR2 = (bn2 & ~31) + 16 * ((bc2 >> 2) & 1) + 4 * (bc2 >> 3) + (bc2 & 3);
    const int bR = (ROWMAP == 1 || ROWMAP == 3 || ROWMAP == 5 || ROWMAP == 6) ? 2 * lane : ROWMAP == 2 ? bR2 : bR_o, bn = (ROWMAP == 1 || ROWMAP == 3 || ROWMAP == 5 || ROWMAP == 6) ? (bR & ~31) + perm32(bR & 31) : ROWMAP == 2 ? bn2 : bn_o;
    const unsigned vbo = (unsigned)((ROWMAP ? 8 * wid : bk_o) * wf.ldw + bn) * 4u;
    const int wb0 = (ROWMAP == 1 || ROWMAP == 5) ? bR * 128 + ((wid ^ (lane & 7)) << 4) : ROWMAP == 0 ? lds_byte(bR_o, bk_o) : lds_byte(bR, 8 * wid), wb1 = (ROWMAP == 1 || ROWMAP == 5) ? wb0 + 128 : ROWMAP == 0 ? lds_byte(bR_o + 1, bk_o) : lds_byte(bR + 1, 8 * wid);
    const int boff0 = (ROWMAP == 1 || ROWMAP == 6) ? (wc * 32 + fr) * 128 + ((fq ^ (fr >> 1)) << 4) : lds_byte(wc * 32 + fr, fq * 8), boff1 = (ROWMAP == 1 || ROWMAP == 6) ? (wc * 32 + fr) * 128 + (((fq + 4) ^ (fr >> 1)) << 4) : boff0 + 1024;
    const size_t ldwb = (size_t)wf.ldw * 4, kstepB = (size_t)BK * ldwb;
#define PG8_SA(b, h) (((b) * 2 + (h)) * HTB)
#define PG8_SB(b, h) ((4 + (b) * 2 + (h)) * HTB)
#define PG8_STAGE(bufoff, gbase, voff) do { _Pragma("unroll") for (int _i = 0; _i < 2; ++_i) \
        { gptr _t; asm volatile("s_mov_b32 m0, %1\n\ts_mov_b64 %0, %3\n\tglobal_load_lds_dwordx4 %2, %0" : "=&s"(_t) : "s"(ldsb + (unsigned)(bufoff) + ldsw + _i * 8192u), "v"((voff)[_i]), "s"((gptr)(gbase)) : "memory"); } } while (0)
#define PG8_LDAH(dst, b, h, mh) do { _Pragma("unroll") for (int m = 0; m < 2; ++m) _Pragma("unroll") for (int k = 0; k < 2; ++k) dst[m][k] = *(const PG8_LAS bf16x8*)(lds + PG8_SA(b, h) + aoff + (2 * (mh) + m) * 2048 + k * 1024); } while (0)
#define PG8_LDB(dst, b, h) do { _Pragma("unroll") for (int n = 0; n < 2; ++n) { dst[n][0] = *(const PG8_LAS bf16x8*)(lds + PG8_SB(b, h) + boff0 + n * 2048); dst[n][1] = *(const PG8_LAS bf16x8*)(lds + PG8_SB(b, h) + boff1 + n * 2048); } } while (0)
#define PG8_MMAH(ai, mh) do { __builtin_amdgcn_s_setprio(1); _Pragma("unroll") for (int m = 0; m < 2; ++m) _Pragma("unroll") for (int n = 0; n < 2; ++n) _Pragma("unroll") for (int k = 0; k < 2; ++k) { \
        acc[ai][0][2 * (mh) + m][n] = __builtin_amdgcn_mfma_f32_16x16x32_bf16(B0[n][k], Ah[m][k], acc[ai][0][2 * (mh) + m][n], 0, 0, 0); \
        acc[ai][1][2 * (mh) + m][n] = __builtin_amdgcn_mfma_f32_16x16x32_bf16(B1[n][k], Ah[m][k], acc[ai][1][2 * (mh) + m][n], 0, 0, 0); } __builtin_amdgcn_s_setprio(0); } while (0)
#define PG8_BLOAD(X, src) do { _Pragma("unroll") for (int _j = 0; _j < 8; ++_j) { const gptr _sj = (gptr)(src) + (size_t)_j * ldwb; gptr _t; asm volatile("s_mov_b64 %1, %3\n\tglobal_load_dwordx2 %0, %2, %1" : "=&v"(X[_j]), "=&s"(_t) : "v"(vbo), "s"(_sj) : "memory"); } } while (0)
#define PG8_BWRITE(X, bufoff) do { u32x4 _w0, _w1; \
        _w0.x = cvt_pk_bf16(X[0].x, X[1].x); _w0.y = cvt_pk_bf16(X[2].x, X[3].x); _w0.z = cvt_pk_bf16(X[4].x, X[5].x); _w0.w = cvt_pk_bf16(X[6].x, X[7].x); \
        _w1.x = cvt_pk_bf16(X[0].y, X[1].y); _w1.y = cvt_pk_bf16(X[2].y, X[3].y); _w1.z = cvt_pk_bf16(X[4].y, X[5].y); _w1.w = cvt_pk_bf16(X[6].y, X[7].y); \
        *(PG8_LAS u32x4*)(lds + (bufoff) + wb0) = _w0; *(PG8_LAS u32x4*)(lds + (bufoff) + wb1) = _w1; } while (0)
#define PG8_WAIT_V(n) asm volatile("s_waitcnt vmcnt(" #n ")" ::: "memory")
#define PG8_WAIT_L(n) asm volatile("s_waitcnt lgkmcnt(" #n ")" ::: "memory")
#define PG8_BAR __builtin_amdgcn_s_barrier()
#define PG8_SCHED __builtin_amdgcn_sched_barrier(0)
#define PG8_GVOFF(u, vo) do { if constexpr (GATHER) { _Pragma("unroll") for (int _h = 0; _h < 2; ++_h) _Pragma("unroll") for (int _i = 0; _i < 2; ++_i) \
        vo[_h][_i] = (unsigned)(S.a_row(u, _h * HALF + RA[_i]) * g.lda + CA[_i]) * 2u; } } while (0)
    Unit cur, nxt; int ui = 0;
    if (!S.next(0, cur)) return;
    f32x4 acc[2][2][4][2];
#pragma unroll
    for (int a = 0; a < 2; ++a)
#pragma unroll
        for (int b = 0; b < 2; ++b)
#pragma unroll
            for (int m = 0; m < 4; ++m)
#pragma unroll
                for (int n = 0; n < 2; ++n) acc[a][b][m][n] = (f32x4){0.f, 0.f, 0.f, 0.f};
    bf16x8 Ah[2][2], B0[2][2], B1[2][2];
    f32x2 X[8], Y[8];
    unsigned nvoffA[2][2];
    PG8_GVOFF(cur, voffA);
    gptr cA = uniform_ptr(S.a_base(cur)); gptr cB0 = uniform_ptr(S.w_base(cur, wf, 0)); gptr cB1 = uniform_ptr(S.w_base(cur, wf, 1));
    PG8_BLOAD(X, cB0); PG8_BLOAD(Y, cB1);
    PG8_STAGE(PG8_SA(0, 0), cA, voffA[0]); PG8_STAGE(PG8_SA(0, 1), cA, voffA[1]);
    PG8_WAIT_V(12); PG8_BWRITE(X, PG8_SB(0, 0)); PG8_BLOAD(X, cB0 + kstepB);
    PG8_WAIT_V(12); PG8_BWRITE(Y, PG8_SB(0, 1)); PG8_BLOAD(Y, cB1 + kstepB);
    PG8_WAIT_V(8); PG8_BWRITE(X, PG8_SB(1, 0)); PG8_BLOAD(X, cB0 + 2 * kstepB);
    PG8_STAGE(PG8_SA(1, 0), cA + kstep, voffA[0]);
    PG8_WAIT_V(10); PG8_BWRITE(Y, PG8_SB(1, 1)); PG8_BLOAD(Y, cB1 + 2 * kstepB);
    PG8_WAIT_L(0);
    if (wr == 1) PG8_BAR;
    PG8_BAR;
    for (;;) {
        const bool has_next = S.next(ui + 1, nxt);
        const bool hf = S.half(cur);
        const gptr nA = has_next ? uniform_ptr(S.a_base(nxt)) : cA;
        const gptr nB0 = has_next ? uniform_ptr(S.w_base(nxt, wf, 0)) : cB0; const gptr nB1 = has_next ? uniform_ptr(S.w_base(nxt, wf, 1)) : cB1;
        if constexpr (GATHER) { if (has_next) { PG8_GVOFF(nxt, nvoffA); } else {
#pragma unroll
            for (int _h = 0; _h < 2; ++_h)
#pragma unroll
                for (int _i = 0; _i < 2; ++_i) nvoffA[_h][_i] = voffA[_h][_i]; } }
        for (int t = 0; t < nt; t += 2) {
            const bool last = (t == nt - 2);
            const gptr a1 = cA + (size_t)(t + 1) * kstep;
            const gptr a2 = last ? nA : cA + (size_t)(t + 2) * kstep; const gptr a3 = a2 + kstep;
            unsigned va0[2], va1[2];
            if constexpr (GATHER) { va0[0] = last ? nvoffA[0][0] : voffA[0][0]; va0[1] = last ? nvoffA[0][1] : voffA[0][1]; va1[0] = last ? nvoffA[1][0] : voffA[1][0]; va1[1] = last ? nvoffA[1][1] : voffA[1][1]; }
            else { va0[0] = voffA[0][0]; va0[1] = voffA[0][1]; va1[0] = voffA[1][0]; va1[1] = voffA[1][1]; }
            const size_t o3 = (t + 3 < nt) ? (size_t)(t + 3) * kstepB : (size_t)(t + 3 - nt) * kstepB, o4 = (t + 4 < nt) ? (size_t)(t + 4) * kstepB : (size_t)(t + 4 - nt) * kstepB;
            const gptr x3 = ((t + 3 < nt) ? cB0 : nB0) + o3; const gptr y3 = ((t + 3 < nt) ? cB1 : nB1) + o3;
            const gptr x4 = ((t + 4 < nt) ? cB0 : nB0) + o4; const gptr y4 = ((t + 4 < nt) ? cB1 : nB1) + o4;
            PG8_LDB(B0, 0, 0); PG8_LDB(B1, 0, 1); PG8_SCHED; PG8_LDAH(Ah, 0, 0, 0); PG8_STAGE(PG8_SA(1, 1), a1, voffA[1]);
            PG8_WAIT_L(0); PG8_BAR; PG8_MMAH(0, 0); PG8_BAR; PG8_SCHED;
            PG8_LDAH(Ah, 0, 0, 1); PG8_WAIT_V(12); PG8_BWRITE(X, PG8_SB(0, 0)); PG8_BLOAD(X, x3);
            PG8_WAIT_L(0); PG8_BAR; PG8_MMAH(0, 1); PG8_BAR; PG8_SCHED;
            PG8_LDAH(Ah, 0, 1, 0); PG8_STAGE(PG8_SA(0, 0), a2, va0);
            PG8_WAIT_L(0); PG8_BAR; if (!hf) { PG8_MMAH(1, 0); } PG8_BAR; PG8_SCHED;
            PG8_LDAH(Ah, 0, 1, 1); PG8_WAIT_V(10); PG8_BWRITE(Y, PG8_SB(0, 1)); PG8_BLOAD(Y, y3);
            PG8_WAIT_L(0); PG8_BAR; if (!hf) { PG8_MMAH(1, 1); } PG8_BAR; PG8_SCHED;
            PG8_LDB(B0, 1, 0); PG8_LDB(B1, 1, 1); PG8_SCHED; PG8_LDAH(Ah, 1, 0, 0); PG8_STAGE(PG8_SA(0, 1), a2, va1);
            PG8_WAIT_L(0); PG8_BAR; PG8_MMAH(0, 0); PG8_BAR; PG8_SCHED;
            PG8_LDAH(Ah, 1, 0, 1); PG8_WAIT_V(12); PG8_BWRITE(X, PG8_SB(1, 0)); PG8_BLOAD(X, x4);
            PG8_WAIT_L(0); PG8_BAR; PG8_MMAH(0, 1); PG8_BAR; PG8_SCHED;
            PG8_LDAH(Ah, 1, 1, 0); PG8_STAGE(PG8_SA(1, 0), a3, va0);
            PG8_WAIT_L(0); PG8_BAR; if (!hf) { PG8_MMAH(1, 0); } PG8_BAR; PG8_SCHED;
            PG8_LDAH(Ah, 1, 1, 1); PG8_WAIT_V(10); PG8_BWRITE(Y, PG8_SB(1, 1)); PG8_BLOAD(Y, y4);
            PG8_WAIT_L(0); PG8_BAR; if (!hf) { PG8_MMAH(1, 1); } PG8_BAR; PG8_SCHED;
        }
        if (wr == 0) PG8_BAR;
        E(acc, cur, wr, wc, fr, fq);
        if (!has_next) break;
#pragma unroll
        for (int a = 0; a < 2; ++a)
#pragma unroll
            for (int b = 0; b < 2; ++b)
#pragma unroll
                for (int m = 0; m < 4; ++m)
#pragma unroll
                    for (int n = 0; n < 2; ++n) acc[a][b][m][n] = (f32x4){0.f, 0.f, 0.f, 0.f};
        cur = nxt; cA = nA; cB0 = nB0; cB1 = nB1; ++ui;
        if constexpr (GATHER) {
#pragma unroll
            for (int _h = 0; _h < 2; ++_h)
#pragma unroll
                for (int _i = 0; _i < 2; ++_i) voffA[_h][_i] = nvoffA[_h][_i]; }
        if (wr == 1) PG8_BAR;
    }
    PG8_WAIT_V(0);
    PG8_BAR;
#undef PG8_SA
#undef PG8_SB
#undef PG8_STAGE
#undef PG8_LDAH
#undef PG8_LDB
#undef PG8_MMAH
#undef PG8_BLOAD
#undef PG8_BWRITE
#undef PG8_WAIT_V
#undef PG8_WAIT_L
#undef PG8_BAR
#undef PG8_SCHED
#undef PG8_GVOFF
}
struct EpiBf16Plain {
    static constexpr bool PERM = true;
    bf16_t* O; size_t ldc;
    __device__ __forceinline__ void operator()(const f32x4 (&acc)[2][2][4][2], const Unit& u, int wr, int wc, int fr, int fq) const {
        const int row0 = u.pm * BM + wr * 64 + fr, col0 = u.pn * BM + wc * 32 + 8 * fq;
#pragma unroll
        for (int ai = 0; ai < 2; ++ai)
#pragma unroll
            for (int m = 0; m < 4; ++m) { bf16_t* rowp = O + (size_t)(row0 + ai * HALF + m * 16) * ldc + col0;
#pragma unroll
                for (int bj = 0; bj < 2; ++bj) { const f32x4 v0 = acc[ai][bj][m][0], v1 = acc[ai][bj][m][1];
                    u32x4 w; w.x = cvt_pk_bf16(v0[0], v0[1]); w.y = cvt_pk_bf16(v0[2], v0[3]); w.z = cvt_pk_bf16(v1[0], v1[1]); w.w = cvt_pk_bf16(v1[2], v1[3]);
                    __builtin_nontemporal_store(w, (u32x4*)(rowp + bj * HALF)); } }
    }
};

struct EpiBrA {
    static constexpr bool PERM = true;
    bf16_t* T1S; const bf16_t* ZP;
    __device__ __forceinline__ void operator()(const f32x4 (&acc)[2][2][4][2], const Unit& u, int wr, int wc, int fr, int fq) const {
        const int row0 = u.pm * BM + wr * 64 + fr, col0 = u.pn * BM + wc * 32 + 8 * fq;
        u32x4 gq[2][4][2];
#pragma unroll
        for (int ai = 0; ai < 2; ++ai)
#pragma unroll
            for (int m = 0; m < 4; ++m) { const size_t pr = (size_t)prow_of(row0 + ai * HALF + m * 16) * NIN + C_GA;
#pragma unroll
                for (int bj = 0; bj < 2; ++bj) gq[ai][m][bj] = *(const u32x4*)(ZP + pr + col0 + bj * HALF); }
        __builtin_amdgcn_sched_barrier(0);
#pragma unroll
        for (int ai = 0; ai < 2; ++ai)
#pragma unroll
            for (int m = 0; m < 4; ++m) { const int row = row0 + ai * HALF + m * 16;
#pragma unroll
                for (int bj = 0; bj < 2; ++bj) { const int col = col0 + bj * HALF; const u32x4 gw = gq[ai][m][bj];
                    const f32x4 v0 = acc[ai][bj][m][0], v1 = acc[ai][bj][m][1]; u32x4 w;
                    w.x = cvt_pk_bf16(sigmoidf(bf_lo(gw.x)) * v0[0], sigmoidf(bf_hi(gw.x)) * v0[1]); w.y = cvt_pk_bf16(sigmoidf(bf_lo(gw.y)) * v0[2], sigmoidf(bf_hi(gw.y)) * v0[3]);
                    w.z = cvt_pk_bf16(sigmoidf(bf_lo(gw.z)) * v1[0], sigmoidf(bf_hi(gw.z)) * v1[1]); w.w = cvt_pk_bf16(sigmoidf(bf_lo(gw.w)) * v1[2], sigmoidf(bf_hi(gw.w)) * v1[3]);
                    *(u32x4*)(T1S + (size_t)row * DM + col) = w; } }
    }
};
struct EpiBrS {
    static constexpr bool PERM = true;
    const bf16_t* T1S; const bf16_t* ZP; bf16_t* MG;
    __device__ __forceinline__ void operator()(const f32x4 (&acc)[2][2][4][2], const Unit& u, int wr, int wc, int fr, int fq) const {
        const int row0 = u.pm * BM + wr * 64 + fr, col0 = u.pn * BM + wc * 32 + 8 * fq;
#pragma unroll
        for (int ai = 0; ai < 2; ++ai) {
            u32x4 gq[4][2], tq[4][2];
#pragma unroll
            for (int m = 0; m < 4; ++m) { const int row = row0 + ai * HALF + m * 16; const size_t pr = (size_t)prow_of(row) * NIN + C_GS;
#pragma unroll
                for (int bj = 0; bj < 2; ++bj) { gq[m][bj] = *(const u32x4*)(ZP + pr + col0 + bj * HALF); tq[m][bj] = *(const u32x4*)(T1S + (size_t)row * DM + col0 + bj * HALF); } }
            __builtin_amdgcn_sched_barrier(0);
#pragma unroll
            for (int m = 0; m < 4; ++m) { const int row = row0 + ai * HALF + m * 16;
#pragma unroll
                for (int bj = 0; bj < 2; ++bj) { const int col = col0 + bj * HALF; const u32x4 gw = gq[m][bj], tw = tq[m][bj];
                    const f32x4 v0 = acc[ai][bj][m][0], v1 = acc[ai][bj][m][1]; u32x4 w;
                    w.x = cvt_pk_bf16(bf_lo(tw.x) + sigmoidf(bf_lo(gw.x)) * v0[0], bf_hi(tw.x) + sigmoidf(bf_hi(gw.x)) * v0[1]);
                    w.y = cvt_pk_bf16(bf_lo(tw.y) + sigmoidf(bf_lo(gw.y)) * v0[2], bf_hi(tw.y) + sigmoidf(bf_hi(gw.y)) * v0[3]);
                    w.z = cvt_pk_bf16(bf_lo(tw.z) + sigmoidf(bf_lo(gw.z)) * v1[0], bf_hi(tw.z) + sigmoidf(bf_hi(gw.z)) * v1[1]);
                    w.w = cvt_pk_bf16(bf_lo(tw.w) + sigmoidf(bf_lo(gw.w)) * v1[2], bf_hi(tw.w) + sigmoidf(bf_hi(gw.w)) * v1[3]);
                    *(u32x4*)(MG + (size_t)row * DM + col) = w; } }
            __builtin_amdgcn_sched_barrier(0);
        }
    }
};
struct EpiWo {
    static constexpr bool PERM = false;
    float* U; const float* x; const float* rowstat; const float* g; const float* bt;
    __device__ __forceinline__ void operator()(const f32x4 (&acc)[2][2][4][2], const Unit& u, int wr, int wc, int fr, int fq) const {
        const int row0 = u.pm * BM + wr * 64 + fr, col0 = u.pn * BM + wc * 32 + 4 * fq;
        f32x4 gv[2][2], bv[2][2];
#pragma unroll
        for (int bj = 0; bj < 2; ++bj)
#pragma unroll
            for (int n = 0; n < 2; ++n) { const int c = col0 + bj * HALF + n * 16; gv[bj][n] = *(const f32x4*)(g + c); bv[bj][n] = *(const f32x4*)(bt + c); }
#pragma unroll
        for (int ai = 0; ai < 2; ++ai)
#pragma unroll
            for (int mh = 0; mh < 2; ++mh) {
                f32x4 xq[2][2][2]; float mean[2], rstd[2];
#pragma unroll
                for (int mm = 0; mm < 2; ++mm) { const int row = row0 + ai * HALF + (2 * mh + mm) * 16; mean[mm] = rowstat[2 * row]; rstd[mm] = rowstat[2 * row + 1];
#pragma unroll
                    for (int bj = 0; bj < 2; ++bj)
#pragma unroll
                        for (int n = 0; n < 2; ++n) xq[mm][bj][n] = *(const f32x4*)(x + (size_t)row * DM + col0 + bj * HALF + n * 16); }
                __builtin_amdgcn_sched_barrier(0);
#pragma unroll
                for (int mm = 0; mm < 2; ++mm) { const int m = 2 * mh + mm, row = row0 + ai * HALF + m * 16;
#pragma unroll
                    for (int bj = 0; bj < 2; ++bj)
#pragma unroll
                        for (int n = 0; n < 2; ++n) { const int c = col0 + bj * HALF + n * 16;
                            *(f32x4*)(U + (size_t)row * DM + c) = ((xq[mm][bj][n] - mean[mm]) * rstd[mm] * gv[bj][n] + bv[bj][n]) * ALPHA + acc[ai][bj][m][n]; } }
                __builtin_amdgcn_sched_barrier(0);
            }
    }
};
struct EpiGateUp {
    static constexpr bool PERM = true;
    bf16_t* HID;
    __device__ __forceinline__ void operator()(const f32x4 (&acc)[2][2][4][2], const Unit& u, int wr, int wc, int fr, int fq) const {
        const int pos0 = u.pm * BM + wr * 64 + fr, col0 = u.pn * HALF + wc * 32 + 8 * fq;
#pragma unroll
        for (int ai = 0; ai < 2; ++ai)
#pragma unroll
            for (int m = 0; m < 4; ++m) { const int pos = pos0 + ai * HALF + m * 16;
                const f32x4 g0 = acc[ai][0][m][0], g1 = acc[ai][0][m][1], u0 = acc[ai][1][m][0], u1 = acc[ai][1][m][1]; u32x4 w;
                w.x = cvt_pk_bf16(siluf(g0[0]) * u0[0], siluf(g0[1]) * u0[1]); w.y = cvt_pk_bf16(siluf(g0[2]) * u0[2], siluf(g0[3]) * u0[3]);
                w.z = cvt_pk_bf16(siluf(g1[0]) * u1[0], siluf(g1[1]) * u1[1]); w.w = cvt_pk_bf16(siluf(g1[2]) * u1[2], siluf(g1[3]) * u1[3]);
                *(u32x4*)(HID + (size_t)pos * DE + col0) = w; }
    }
};
struct MoeTiles { const PG8_LAS int* te; const PG8_LAS int* tf; const PG8_LAS int* tn; const int* list_ent; const float* list_w; };
struct EpiDown {
    static constexpr bool PERM = true;
    bf16_t* Y; MoeTiles T;
    __device__ __forceinline__ void operator()(const f32x4 (&acc)[2][2][4][2], const Unit& u, int wr, int wc, int fr, int fq) const {
        const int r0 = wr * 64 + fr, col0 = u.pn * BM + wc * 32 + 8 * fq;
        const int e = T.te[u.pm], first = T.tf[u.pm], nv = T.tn[u.pm];
        int ent[2][4]; float wt[2][4];
#pragma unroll
        for (int ai = 0; ai < 2; ++ai)
#pragma unroll
            for (int m = 0; m < 4; ++m) { const int r = r0 + ai * HALF + m * 16, rc = r < nv ? r : nv - 1;
                ent[ai][m] = T.list_ent[e * MR + first + rc]; wt[ai][m] = T.list_w[e * MR + first + rc]; }
#pragma unroll
        for (int ai = 0; ai < 2; ++ai)
#pragma unroll
            for (int m = 0; m < 4; ++m) { const int r = r0 + ai * HALF + m * 16;
                if (r < nv) {
#pragma unroll
                    for (int bj = 0; bj < 2; ++bj) { const f32x4 v0 = acc[ai][bj][m][0] * wt[ai][m], v1 = acc[ai][bj][m][1] * wt[ai][m]; u32x4 w;
                        w.x = cvt_pk_bf16(v0[0], v0[1]); w.y = cvt_pk_bf16(v0[2], v0[3]); w.z = cvt_pk_bf16(v1[0], v1[1]); w.w = cvt_pk_bf16(v1[2], v1[3]);
                        *(u32x4*)(Y + (size_t)ent[ai][m] * DM + col0 + bj * HALF) = w; } } }
    }
};
struct MoeOrder {
    int nN, nwg, G, c; const bf16_t* A; int lda; const bf16_t* Bt; size_t b_stride; int ldb; MoeTiles T; bool gather;
    __device__ bool next(int i, Unit& u) const { const long L = (long)i * G + c; if (L >= nwg) return false; u.pm = (int)(L / nN); u.pn = (int)(L % nN); return true; }
    __device__ __forceinline__ const char* a_base(const Unit& u) const { return gather ? (const char*)A : (const char*)(A + (size_t)u.pm * BM * lda); }
    __device__ __forceinline__ const char* b_base(const Unit& u) const { return (const char*)(Bt + (size_t)T.te[u.pm] * b_stride + (size_t)u.pn * BM * ldb); }
    __device__ __forceinline__ const char* w_base(const Unit& u, const WF32& wf, int h) const { return (const char*)((h ? wf.W1 : wf.W0) + (size_t)T.te[u.pm] * wf.estride + (size_t)u.pn * wf.pn_step); }
    __device__ __forceinline__ bool half(const Unit& u) const { return T.tn[u.pm] <= HALF; }
    __device__ __forceinline__ int a_row(const Unit& u, int r) const { const int idx = T.list_ent[T.te[u.pm] * MR + T.tf[u.pm] + (r < T.tn[u.pm] ? r : 0)]; return r < T.tn[u.pm] ? (idx >> 1) : 0; }
};
}

#define XB_TMO      128
#define XB_XCNT(j)  (256  + 64 * (j))
#define XB_XSUB(j)  (1280 + 64 * (j))
#define XB_XGEN(j)  (2304 + 64 * (j))
#define XB_TOP      3328
#define XB_TOPGEN   3392
#define XCD_BAR_WORDS 3456
#define XB_SPIN_CAP (1u << 18)
__device__ __forceinline__ unsigned xb_ld(unsigned* p)              { return __hip_atomic_load(p, __ATOMIC_RELAXED, __HIP_MEMORY_SCOPE_AGENT); }
__device__ __forceinline__ unsigned xb_add(unsigned* p, unsigned v) { return __hip_atomic_fetch_add(p, v, __ATOMIC_RELAXED, __HIP_MEMORY_SCOPE_AGENT); }
__device__ __forceinline__ unsigned xb_xcc_id() { return (unsigned)__builtin_amdgcn_s_getreg((3 << 11) | 20) & 0xFu; }
#define XB_SPIN(cond, bar) do { unsigned _sp = 0; while (cond) { __builtin_amdgcn_s_sleep(1); \
    if ((++_sp & 255u) == 0u) { if (xb_ld(&(bar)[XB_TMO])) break; if (_sp > XB_SPIN_CAP) { atomicAdd(&(bar)[XB_TMO], 1u); break; } } } } while (0)
struct XcdBarrier { unsigned* bar; unsigned x; volatile LAS unsigned* st; };
__device__ __forceinline__ XcdBarrier xcd_barrier_post(unsigned* bar, volatile LAS unsigned* st) {
    XcdBarrier b; b.bar = bar; b.x = xb_xcc_id(); b.st = st;
    if (threadIdx.x == 0) (void)xb_add(&bar[XB_XCNT(b.x)], 1u);
    return b;
}
__device__ __forceinline__ void xcd_barrier_complete(unsigned* bar, unsigned x, unsigned& nloc, unsigned& nx) {
    const unsigned G = gridDim.x * gridDim.y * gridDim.z;
    unsigned sum, cnt, mine, sp = 0u;
    for (;;) {
        sum = 0u; cnt = 0u; mine = 0u;
#pragma unroll
        for (unsigned j = 0; j < 16; ++j) { const unsigned c = xb_ld(&bar[XB_XCNT(j)]); sum += c; cnt += (c > 0u) ? 1u : 0u; mine = (j == x) ? c : mine; }
        if (sum == G) break;
        __builtin_amdgcn_s_sleep(1);
        if ((++sp & 255u) == 0u) { if (xb_ld(&bar[XB_TMO])) break; if (sp > XB_SPIN_CAP) { atomicAdd(&bar[XB_TMO], 1u); break; } }
    }
    nloc = mine > 0u ? mine : 1u; nx = cnt > 0u ? cnt : 1u;
}
__device__ __forceinline__ void xcd_barrier(const XcdBarrier& b) {
    asm volatile("s_waitcnt vmcnt(0)" ::: "memory");
    __syncthreads();
    if (threadIdx.x == 0) {
        unsigned* bar = b.bar;
        __builtin_amdgcn_s_waitcnt(0);
        unsigned nloc = b.st[0], nx = b.st[1];
        if (nloc == 0u) { xcd_barrier_complete(bar, b.x, nloc, nx); b.st[0] = nloc; b.st[1] = nx; }
        const unsigned old = xb_add(&bar[XB_XSUB(b.x)], 1u);
        const unsigned gen = old / nloc;
        if (old + 1u == (gen + 1u) * nloc) {
            __builtin_amdgcn_fence(__ATOMIC_RELEASE, "agent");
            asm volatile("s_waitcnt vmcnt(0)" ::: "memory");
            const unsigned og = xb_add(&bar[XB_TOP], 1u);
            const unsigned tg = og / nx;
            if (og + 1u == (tg + 1u) * nx) xb_add(&bar[XB_TOPGEN], 1u);
            else XB_SPIN(xb_ld(&bar[XB_TOPGEN]) == tg, bar);
            __builtin_amdgcn_fence(__ATOMIC_ACQUIRE, "agent");
            xb_add(&bar[XB_XGEN(b.x)], 1u);
            asm volatile("s_waitcnt vmcnt(0)" ::: "memory");
        } else {
            XB_SPIN(xb_ld(&bar[XB_XGEN(b.x)]) == gen, bar);
            __builtin_amdgcn_fence(__ATOMIC_ACQUIRE, "agent");
            asm volatile("s_waitcnt vmcnt(0)" ::: "memory");
        }
    }
    __syncthreads();
}

DEVINL void tr_item(const float* __restrict__ W, int ld, int c0, int k0, bf16_t* __restrict__ WT, size_t drow0, int K, LAS float* scr, int lane, bool zero) {
#pragma unroll
    for (int i = 0; i < 8; ++i) { const int kk = 8 * i + (lane >> 3), cc = 4 * (lane & 7);
        const pg8::f32x4 w4 = zero ? (pg8::f32x4){0.f, 0.f, 0.f, 0.f} : __builtin_nontemporal_load((const pg8::f32x4*)(W + (size_t)(k0 + kk) * ld + c0 + cc));
        scr[kk * 33 + cc] = w4[0]; scr[kk * 33 + cc + 1] = w4[1]; scr[kk * 33 + cc + 2] = w4[2]; scr[kk * 33 + cc + 3] = w4[3]; }
    LDS_WAIT();
    const int c = lane & 7;
#pragma unroll
    for (int j = 0; j < 4; ++j) { const int n = (lane >> 3) + 8 * j; const LAS float* s = scr + (8 * c) * 33 + n;
        uint4 o; o.x = pk2(s[0 * 33], s[1 * 33]); o.y = pk2(s[2 * 33], s[3 * 33]); o.z = pk2(s[4 * 33], s[5 * 33]); o.w = pk2(s[6 * 33], s[7 * 33]);
        *(uint4*)(WT + (drow0 + n) * (size_t)K + k0 + 8 * c) = o; }
    LDS_WAIT();
}
struct P { const float* in[26]; float* out; unsigned char* ws; int ph_lo, ph_hi; };

DEVINL void phase_weights(const P& p, LAS float* scr, int gw, int NGW, int lane, bool moe, int it0 = 0, int it1 = 1 << 30) {
    unsigned char* ws = p.ws;
    constexpr int I_IN = 32 * 344, I_BRA = 16 * 64, I_BRS = 32 * 64, I_O = 32 * 64, I_GU = 64 * 32 * 32, I_DN = 64 * 8 * 64;
    constexpr int NDENSE = I_IN + I_BRA + I_BRS + I_O, NMOE = I_GU + I_DN;
    const int itend = (moe ? NMOE : NDENSE) < it1 ? (moe ? NMOE : NDENSE) : it1;
    for (int it = it0 + gw; it < itend; it += NGW) {
        int r = moe ? it + NDENSE : it;
        if (r < I_IN) { const int kb = r / 344, nb = r % 344, n = nb * 32; int c0 = n; bool zero = false;
            if (n < 6656) c0 = n; else if (n < 10752) c0 = n + 32; else if (n < 10784) c0 = n - 4096; else { zero = true; c0 = 0; }
            tr_item(p.in[4], 10784, c0, kb * 64, (bf16_t*)(ws + WS_WIN), (size_t)n, DM, scr, lane, zero); continue; } r -= I_IN;
        if (r < I_BRA) { const int kb = r / 64, nb = r % 64; tr_item(p.in[12], DM, nb * 32, kb * 64, (bf16_t*)(ws + WS_WBRA), (size_t)nb * 32, 1024, scr, lane, false); continue; } r -= I_BRA;
        if (r < I_BRS) { const int kb = r / 64, nb = r % 64; tr_item(p.in[13], DM, nb * 32, kb * 64, (bf16_t*)(ws + WS_WBRS), (size_t)nb * 32, DM, scr, lane, false); continue; } r -= I_BRS;
        if (r < I_O) { const int kb = r / 64, nb = r % 64; tr_item(p.in[14], DM, nb * 32, kb * 64, (bf16_t*)(ws + WS_WO), (size_t)nb * 32, DM, scr, lane, false); continue; } r -= I_O;
        if (r < I_GU) { const int e = r >> 10, q = r & 1023, kb = q >> 5, nb = q & 31, pn = nb >> 3, w = nb & 7;
            const float* src = (w < 4 ? p.in[21] : p.in[22]) + (size_t)e * DM * DE;
            tr_item(src, DE, pn * 128 + (w & 3) * 32, kb * 64, (bf16_t*)(ws + WS_WGU), (size_t)e * 1024 + nb * 32, DM, scr, lane, false); continue; } r -= I_GU;
        { const int e = r >> 9, q = r & 511, kb = q >> 6, nb = q & 63;
            tr_item(p.in[23] + (size_t)e * DE * DM, DM, nb * 32, kb * 64, (bf16_t*)(ws + WS_WDN), (size_t)e * DM + nb * 32, DE, scr, lane, false); }
    }
}
DEVINL void ln0_row(const P& p, int R, int lane) {
    const int b = R / LP, pp = R % LP;
    uint2* orow = (uint2*)((bf16_t*)(p.ws + WS_H0) + (size_t)R * DM);
    if (pp < 112) {
#pragma unroll
        for (int j = 0; j < 8; ++j) orow[lane + 64 * j] = make_uint2(0u, 0u);
        return;
    }
    const float* src = pp < 128 ? p.in[1] + (size_t)(pp - 112) * DM : p.in[0] + ((size_t)b * SEQ + (pp - 128)) * DM;
    const float* g = p.in[2]; const float* bt = p.in[3];
    float4 v[8]; float s = 0.f;
#pragma unroll
    for (int j = 0; j < 8; ++j) { v[j] = ((const float4*)src)[lane + 64 * j]; s += (v[j].x + v[j].y) + (v[j].z + v[j].w); }
    const float mean = wave_sum(s) * (1.f / DM); float q = 0.f;
#pragma unroll
    for (int j = 0; j < 8; ++j) { v[j].x -= mean; v[j].y -= mean; v[j].z -= mean; v[j].w -= mean; q += (v[j].x * v[j].x + v[j].y * v[j].y) + (v[j].z * v[j].z + v[j].w * v[j].w); }
    const float rstd = 1.f / sqrtf(wave_sum(q) * (1.f / DM) + LN_EPS);
#pragma unroll
    for (int j = 0; j < 8; ++j) {
        const float4 gg = ((const float4*)g)[lane + 64 * j], bb = ((const float4*)bt)[lane + 64 * j];
        orow[lane + 64 * j] = make_uint2(pk2(v[j].x * rstd * gg.x + bb.x, v[j].y * rstd * gg.y + bb.y), pk2(v[j].z * rstd * gg.z + bb.z, v[j].w * rstd * gg.w + bb.w));
    }
    if (pp >= 128 && lane == 0) { float* rowstat = (float*)(p.ws + OFF_ROWSTAT); const int r = b * SEQ + pp - 128; rowstat[2 * r] = mean; rowstat[2 * r + 1] = rstd; }
}
template <bool DISPATCH> DEVINL void ln1_router_row(const P& p, int r, int rnext, float4 (&vin)[8], int lane, LAS float* scr, const LAS float* wrgl, LAS int* res) {
    const float* U = (const float*)(p.ws + WS_U); bf16_t* H1B = (bf16_t*)(p.ws + WS_H1B);
    const float* g1 = p.in[15]; const float* b1 = p.in[16]; const float* brg = p.in[18]; const float* bre = p.in[20];
    const float* wreg = (const float*)(p.ws + OFF_WREG);
    float4 v[8]; float s = 0.f;
#pragma unroll
    for (int j = 0; j < 8; ++j) { v[j] = vin[j]; s += (v[j].x + v[j].y) + (v[j].z + v[j].w); }
    if (rnext >= 0) {
        const float4* upn = (const float4*)(U + (size_t)rnext * DM);
#pragma unroll
        for (int j = 0; j < 8; ++j) vin[j] = upn[lane + 64 * j]; }
    const float mean = wave_sum(s) * (1.f / DM); float q = 0.f;
#pragma unroll
    for (int j = 0; j < 8; ++j) { v[j].x -= mean; v[j].y -= mean; v[j].z -= mean; v[j].w -= mean; q += (v[j].x * v[j].x + v[j].y * v[j].y) + (v[j].z * v[j].z + v[j].w * v[j].w); }
    const float rstd = 1.f / sqrtf(wave_sum(q) * (1.f / DM) + LN_EPS);
    if (DISPATCH && lane == 0) { float* rs1 = (float*)(p.ws + OFF_ROWSTAT1); rs1[2 * r] = mean; rs1[2 * r + 1] = rstd; }
    uint2* hb = (uint2*)(H1B + (size_t)r * DM);
#pragma unroll
    for (int j = 0; j < 8; ++j) {
        const float4 gg = ((const float4*)g1)[lane + 64 * j], bb = ((const float4*)b1)[lane + 64 * j];
        v[j].x = v[j].x * rstd * gg.x + bb.x; v[j].y = v[j].y * rstd * gg.y + bb.y; v[j].z = v[j].z * rstd * gg.z + bb.z; v[j].w = v[j].w * rstd * gg.w + bb.w;
        if (DISPATCH) hb[lane + 64 * j] = make_uint2(pk2(v[j].x, v[j].y), pk2(v[j].z, v[j].w));
        *(LAS pg8::f32x4*)(scr + 4 * (lane + 64 * j)) = (pg8::f32x4){v[j].x, v[j].y, v[j].z, v[j].w};
    }
    LDS_WAIT();
    float lg[8];
#pragma unroll
    for (int c = 0; c < 8; ++c) lg[c] = 0.f;
#pragma unroll 8
    for (int t = 0; t < 32; ++t) {
        const int i = lane + 64 * t; const float h = scr[i];
        const pg8::f32x4 w0 = *(const LAS pg8::f32x4*)(wrgl + i * 8), w1 = *(const LAS pg8::f32x4*)(wrgl + i * 8 + 4);
        lg[0] += h * w0[0]; lg[1] += h * w0[1]; lg[2] += h * w0[2]; lg[3] += h * w0[3];
        lg[4] += h * w1[0]; lg[5] += h * w1[1]; lg[6] += h * w1[2]; lg[7] += h * w1[3];
    }
#pragma unroll
    for (int c = 0; c < 8; ++c) lg[c] = wave_sum(lg[c]) + brg[c];
    int gi = 0; float gm = lg[0];
#pragma unroll
    for (int c = 1; c < 8; ++c) if (lg[c] > gm) { gm = lg[c]; gi = c; }
    float den = 0.f;
#pragma unroll
    for (int c = 0; c < 8; ++c) den += __expf(lg[c] - gm);
    const float ptop = 1.f / den;
    float sel[8];
#pragma unroll
    for (int c = 0; c < 8; ++c) sel[c] = 0.f;
    const float* wgp = wreg + ((size_t)gi * DM + lane) * 8;
#pragma unroll 8
    for (int t = 0; t < 32; ++t) {
        const float h = scr[lane + 64 * t];
        const float4 w0 = *(const float4*)(wgp + (size_t)t * 512), w1 = *(const float4*)(wgp + (size_t)t * 512 + 4);
        sel[0] += h * w0.x; sel[1] += h * w0.y; sel[2] += h * w0.z; sel[3] += h * w0.w;
        sel[4] += h * w1.x; sel[5] += h * w1.y; sel[6] += h * w1.z; sel[7] += h * w1.w;
    }
    {   const float4 be0 = ((const float4*)(bre + gi * 8))[0], be1 = ((const float4*)(bre + gi * 8))[1];
        sel[0] = wave_sum(sel[0]) + be0.x; sel[1] = wave_sum(sel[1]) + be0.y; sel[2] = wave_sum(sel[2]) + be0.z; sel[3] = wave_sum(sel[3]) + be0.w;
        sel[4] = wave_sum(sel[4]) + be1.x; sel[5] = wave_sum(sel[5]) + be1.y; sel[6] = wave_sum(sel[6]) + be1.z; sel[7] = wave_sum(sel[7]) + be1.w; }
    LDS_WAIT();
    int i1 = 0; float m1 = sel[0];
#pragma unroll
    for (int jj = 1; jj < 8; ++jj) if (sel[jj] > m1) { m1 = sel[jj]; i1 = jj; }
    int i2 = -1; float m2 = -3.0e38f;
#pragma unroll
    for (int jj = 0; jj < 8; ++jj) if (jj != i1 && sel[jj] > m2) { m2 = sel[jj]; i2 = jj; }
    const float e2 = __expf(m2 - m1), w1 = ptop / (1.f + e2), w2 = ptop * e2 / (1.f + e2);
    if (!DISPATCH) { asm volatile("" :: "v"(w1), "v"(w2), "v"(i1), "v"(i2)); return; }
    if (lane == 0) { res[0] = gi * 8 + i1; res[1] = gi * 8 + i2; res[2] = __float_as_int(w1); res[3] = __float_as_int(w2); }
}
DEVINL void ln2_row(const P& p, int r, int lane) {
    const float* U = (const float*)(p.ws + WS_U); const bf16_t* Y = (const bf16_t*)(p.ws + WS_Y); const float* g1 = p.in[15]; const float* b1 = p.in[16]; const float* g2 = p.in[24]; const float* b2 = p.in[25];
    const float* rs1 = (const float*)(p.ws + OFF_ROWSTAT1); const float m1 = rs1[2 * r], r1 = rs1[2 * r + 1];
    const float4* up = (const float4*)(U + (size_t)r * DM);
    const uint2* y0 = (const uint2*)(Y + (size_t)(2 * r) * DM); const uint2* y1 = (const uint2*)(Y + (size_t)(2 * r + 1) * DM);
    float4 v[8]; float s = 0.f;
#pragma unroll
    for (int j = 0; j < 8; ++j) {
        const float4 u = up[lane + 64 * j]; const uint2 a = y0[lane + 64 * j], c = y1[lane + 64 * j];
        const float4 gg = ((const float4*)g1)[lane + 64 * j], bb = ((const float4*)b1)[lane + 64 * j];
        v[j].x = ALPHA * ((u.x - m1) * r1 * gg.x + bb.x) + bf_lo(a.x) + bf_lo(c.x); v[j].y = ALPHA * ((u.y - m1) * r1 * gg.y + bb.y) + bf_hi(a.x) + bf_hi(c.x);
        v[j].z = ALPHA * ((u.z - m1) * r1 * gg.z + bb.z) + bf_lo(a.y) + bf_lo(c.y); v[j].w = ALPHA * ((u.w - m1) * r1 * gg.w + bb.w) + bf_hi(a.y) + bf_hi(c.y);
        s += (v[j].x + v[j].y) + (v[j].z + v[j].w);
    }
    const float mean = wave_sum(s) * (1.f / DM); float q = 0.f;
#pragma unroll
    for (int j = 0; j < 8; ++j) { v[j].x -= mean; v[j].y -= mean; v[j].z -= mean; v[j].w -= mean; q += (v[j].x * v[j].x + v[j].y * v[j].y) + (v[j].z * v[j].z + v[j].w * v[j].w); }
    const float rstd = 1.f / sqrtf(wave_sum(q) * (1.f / DM) + LN_EPS);
    float4* op = (float4*)(p.out + (size_t)r * DM);
#pragma unroll
    for (int j = 0; j < 8; ++j) {
        const float4 gg = ((const float4*)g2)[lane + 64 * j], bb = ((const float4*)b2)[lane + 64 * j];
        op[lane + 64 * j] = make_float4(v[j].x * rstd * gg.x + bb.x, v[j].y * rstd * gg.y + bb.y, v[j].z * rstd * gg.z + bb.z, v[j].w * rstd * gg.w + bb.w);
    }
}


typedef unsigned u32x4_t __attribute__((ext_vector_type(4)));
typedef unsigned u32x2_t __attribute__((ext_vector_type(2)));
typedef float f32x4_t __attribute__((ext_vector_type(4)));
DEVINL bf16x8 pack8(const float* v) { u32x4_t w; w.x = cvtpk(v[0], v[1]); w.y = cvtpk(v[2], v[3]); w.z = cvtpk(v[4], v[5]); w.w = cvtpk(v[6], v[7]); return __builtin_bit_cast(bf16x8, w); }
#define MFMA32(a, b, c) __builtin_amdgcn_mfma_f32_32x32x16_bf16((a), (b), (c), 0, 0, 0)
constexpr int SSTR = 136;
constexpr int XSTR = 132;
constexpr int SSD_B = 0, SSD_C = 128 * SSTR * 2, SSD_DT = 2 * 128 * SSTR * 2, SSD_ACS = SSD_DT + 4096, SSD_DTW = SSD_ACS + 4096, SSD_RED = SSD_DTW + 4096, SSD_WV = SSD_RED + 4096, SSD_WV_BYTES = 32 * XSTR * 2;
constexpr size_t S_CHUNK = (size_t)SH * SP * SN;
constexpr int NCH = 65;
constexpr size_t BC_TILE = 128 * 128;

DEVINL void conv_block2(const P& p, int b, int c, int col0, int cch0, LAS bf16_t* dst, int tid) {
    const int cp = tid & 63, seg = tid >> 6, ch = cch0 + 2 * cp;
    const float* cw = p.in[5];
    const f32x2_t w0 = *(const f32x2_t*)(cw + ch), w1 = *(const f32x2_t*)(cw + 3072 + ch), w2 = *(const f32x2_t*)(cw + 2 * 3072 + ch), w3 = *(const f32x2_t*)(cw + 3 * 3072 + ch), bs = *(const f32x2_t*)(p.in[6] + ch);
    const bf16_t* base = (const bf16_t*)(p.ws + WS_ZP) + (size_t)b * LP * NIN + col0 + 2 * cp;
    const int pr0 = 128 * c + 16 * seg - 3;
    unsigned raw[19];
#pragma unroll
    for (int i = 0; i < 19; ++i) { const int q = pr0 + i; raw[i] = *(const unsigned*)(base + (size_t)(q > 0 ? q : 0) * NIN); }
#pragma unroll
    for (int i = 0; i < 16; ++i) {
        const float va = siluf(w0[0] * bf_lo(raw[i]) + w1[0] * bf_lo(raw[i + 1]) + w2[0] * bf_lo(raw[i + 2]) + w3[0] * bf_lo(raw[i + 3]) + bs[0]);
        const float vb = siluf(w0[1] * bf_hi(raw[i]) + w1[1] * bf_hi(raw[i + 1]) + w2[1] * bf_hi(raw[i + 2]) + w3[1] * bf_hi(raw[i + 3]) + bs[1]);
        *(LAS unsigned*)(dst + (16 * seg + i) * SSTR + 2 * cp) = cvtpk(va, vb);
    }
}
DEVINL void stage_xT(const P& p, int b, int c, int h, int pt, LAS bf16_t* XT, int lane) {
    const int cp = lane & 15, seg = lane >> 4, ch = h * 64 + pt * 32 + 2 * cp;
    const float* cw = p.in[5];
    const f32x2_t w0 = *(const f32x2_t*)(cw + ch), w1 = *(const f32x2_t*)(cw + 3072 + ch), w2 = *(const f32x2_t*)(cw + 2 * 3072 + ch), w3 = *(const f32x2_t*)(cw + 3 * 3072 + ch), bs = *(const f32x2_t*)(p.in[6] + ch);
    const bf16_t* base = (const bf16_t*)(p.ws + WS_ZP) + (size_t)b * LP * NIN + C_X + ch;
    const int pr0 = 128 * c + 32 * seg - 3;
    unsigned raw[35];
#pragma unroll
    for (int i = 0; i < 35; ++i) { const int q = pr0 + i; raw[i] = *(const unsigned*)(base + (size_t)(q > 0 ? q : 0) * NIN); }
#pragma unroll
    for (int i = 0; i < 32; i += 2) {
        float va[2], vb[2];
#pragma unroll
        for (int e = 0; e < 2; ++e) {
            va[e] = siluf(w0[0] * bf_lo(raw[i + e]) + w1[0] * bf_lo(raw[i + e + 1]) + w2[0] * bf_lo(raw[i + e + 2]) + w3[0] * bf_lo(raw[i + e + 3]) + bs[0]);
            vb[e] = siluf(w0[1] * bf_hi(raw[i + e]) + w1[1] * bf_hi(raw[i + e + 1]) + w2[1] * bf_hi(raw[i + e + 2]) + w3[1] * bf_hi(raw[i + e + 3]) + bs[1]);
        }
        const int sidx = 32 * seg + i;
        *(LAS unsigned*)(XT + (2 * cp) * XSTR + sidx) = cvtpk(va[0], va[1]);
        *(LAS unsigned*)(XT + (2 * cp + 1) * XSTR + sidx) = cvtpk(vb[0], vb[1]);
    }
    LDS_WAIT();
}
DEVINL void conv_pre_item(const P& p, int b, int c, int g, LAS unsigned char* lds, int tid, int w, int lane) {
    asm volatile("" : "+v"(tid)); asm volatile("" : "+s"(w)); lane = tid & 63;
    const int bc = b * NCH + c, h = g * 8 + w;
    LAS bf16_t* Bc = (LAS bf16_t*)(lds + SSD_B); LAS bf16_t* Cc = (LAS bf16_t*)(lds + SSD_C);
    __syncthreads();
    conv_block2(p, b, c, C_B + g * 128, 2048 + g * 128, Bc, tid);
    conv_block2(p, b, c, C_C + g * 128, 2560 + g * 128, Cc, tid);
    LAS bf16_t* XT = (LAS bf16_t*)(lds + SSD_WV + w * SSD_WV_BYTES);
#pragma unroll 1
    for (int pt = 0; pt < 2; ++pt) {
        stage_xT(p, b, c, h, pt, XT, lane);
        bf16_t* dst = (bf16_t*)(p.ws + WS_XCT) + ((size_t)(bc * SH + h) * SP + pt * 32) * 128;
#pragma unroll
        for (int k = 0; k < 8; ++k) { const int idx = lane + 64 * k, row = idx >> 4, j = idx & 15;
            const u32x2_t a = *(const LAS u32x2_t*)(XT + row * XSTR + j * 8), bq = *(const LAS u32x2_t*)(XT + row * XSTR + j * 8 + 4);
            *(u32x4_t*)(dst + row * 128 + j * 8) = (u32x4_t){a.x, a.y, bq.x, bq.y}; }
        LDS_WAIT();
    }
    LDS_WAIT();
    __syncthreads();
    const size_t tile = (size_t)(bc * SG + g) * BC_TILE;
    bf16_t* BCg = (bf16_t*)(p.ws + WS_BCC) + tile; bf16_t* CCg = (bf16_t*)(p.ws + WS_CCC) + tile; bf16_t* BTg = (bf16_t*)(p.ws + WS_BTT) + tile;
#pragma unroll
    for (int k = 0; k < 4; ++k) { const int idx = tid + 512 * k, l = idx >> 4, j = idx & 15;
        *(u32x4_t*)(BCg + l * 128 + j * 8) = *(const LAS u32x4_t*)(Bc + l * SSTR + j * 8);
        *(u32x4_t*)(CCg + l * 128 + j * 8) = *(const LAS u32x4_t*)(Cc + l * SSTR + j * 8); }
#pragma unroll
    for (int k = 0; k < 4; ++k) { const int idx = tid + 512 * k, n = idx >> 4, lc = idx & 15;
        unsigned short e[8];
#pragma unroll
        for (int q = 0; q < 8; ++q) e[q] = Bc[(8 * lc + q) * SSTR + n];
        *(u32x4_t*)(BTg + n * 128 + 8 * lc) = (u32x4_t){(unsigned)e[0] | ((unsigned)e[1] << 16), (unsigned)e[2] | ((unsigned)e[3] << 16), (unsigned)e[4] | ((unsigned)e[5] << 16), (unsigned)e[6] | ((unsigned)e[7] << 16)}; }
    asm volatile("s_waitcnt vmcnt(0)" ::: "memory");
}
DEVINL void conv_c64_piece(const P& p, int piece, LAS unsigned char* lds, int w, int lane) {
    if (piece < 128) {
        const int b = piece >> 6, h = (piece >> 1) & 31, pt = piece & 1, bc = b * NCH + 64;
        LAS bf16_t* XT = (LAS bf16_t*)(lds + SSD_WV + w * SSD_WV_BYTES);
        stage_xT(p, b, 64, h, pt, XT, lane);
        bf16_t* dst = (bf16_t*)(p.ws + WS_XCT) + ((size_t)(bc * SH + h) * SP + pt * 32) * 128;
#pragma unroll
        for (int k = 0; k < 8; ++k) { const int idx = lane + 64 * k, row = idx >> 4, j = idx & 15;
            const u32x2_t a = *(const LAS u32x2_t*)(XT + row * XSTR + j * 8), bq = *(const LAS u32x2_t*)(XT + row * XSTR + j * 8 + 4);
            *(u32x4_t*)(dst + row * 128 + j * 8) = (u32x4_t){a.x, a.y, bq.x, bq.y}; }
        LDS_WAIT();
    } else {
        const int q = piece - 128, seg = q & 7, which = (q >> 3) & 1, g = (q >> 4) & 3, b = q >> 6, bc = b * NCH + 64;
        const int col0 = (which ? C_C : C_B) + g * 128, ch = (which ? 2560 : 2048) + g * 128 + 2 * lane;
        const float* cw = p.in[5];
        const f32x2_t w0 = *(const f32x2_t*)(cw + ch), w1 = *(const f32x2_t*)(cw + 3072 + ch), w2 = *(const f32x2_t*)(cw + 2 * 3072 + ch), w3 = *(const f32x2_t*)(cw + 3 * 3072 + ch), bs = *(const f32x2_t*)(p.in[6] + ch);
        const bf16_t* base = (const bf16_t*)(p.ws + WS_ZP) + (size_t)b * LP * NIN + col0 + 2 * lane;
        const int pr0 = 128 * 64 + 16 * seg - 3;
        unsigned raw[19];
#pragma unroll
        for (int i = 0; i < 19; ++i) raw[i] = *(const unsigned*)(base + (size_t)(pr0 + i) * NIN);
        bf16_t* dst = (bf16_t*)(p.ws + (which ? WS_CCC : WS_BCC)) + (size_t)(bc * SG + g) * BC_TILE + (size_t)(16 * seg) * 128 + 2 * lane;
#pragma unroll
        for (int i = 0; i < 16; ++i) {
            const float va = siluf(w0[0] * bf_lo(raw[i]) + w1[0] * bf_lo(raw[i + 1]) + w2[0] * bf_lo(raw[i + 2]) + w3[0] * bf_lo(raw[i + 3]) + bs[0]);
            const float vb = siluf(w0[1] * bf_hi(raw[i]) + w1[1] * bf_hi(raw[i + 1]) + w2[1] * bf_hi(raw[i + 2]) + w3[1] * bf_hi(raw[i + 3]) + bs[1]);
            *(unsigned*)(dst + i * 128) = cvtpk(va, vb);
        }
    }
}
DEVINL void dt_scan(const P& p, int b, int c, int h, int w, int lane, LAS unsigned char* lds) {
    const bf16_t* ZP = (const bf16_t*)(p.ws + WS_ZP);
    const float dtb = p.in[7][h], a = -__expf(p.in[8][h]);
    LAS float* DT = (LAS float*)(lds + SSD_DT) + w * 128; LAS float* ACS = (LAS float*)(lds + SSD_ACS) + w * 128;
    float dt[2], cs[2];
#pragma unroll
    for (int k = 0; k < 2; ++k) { const int l = lane + 64 * k, pr = 128 * c + l;
        const float raw = bf2f(ZP[((size_t)b * LP + pr) * NIN + C_DT + h]) + dtb;
        dt[k] = (pr < 112) ? 0.f : (raw > 20.f ? raw : log1pf(__expf(raw))); cs[k] = dt[k] * a; }
#pragma unroll
    for (int d = 1; d < 64; d <<= 1) { const float t0 = __shfl_up(cs[0], d), t1 = __shfl_up(cs[1], d); if (lane >= d) { cs[0] += t0; cs[1] += t1; } }
    cs[1] += __shfl(cs[0], 63);
    DT[lane] = dt[0]; DT[lane + 64] = dt[1]; ACS[lane] = cs[0]; ACS[lane + 64] = cs[1];
    LDS_WAIT();
}

DEVINL void ssd1_item(const P& p, int item, LAS unsigned char* lds, int tid, int w, int lane) {
    asm volatile("" : "+v"(tid)); asm volatile("" : "+s"(w)); lane = tid & 63;
    const int g = item & 3, c = (item >> 2) & 63, b = item >> 8, h = g * 8 + w, half = lane >> 5, l31 = lane & 31, bc = b * NCH + c;
    LAS bf16_t* BcT = (LAS bf16_t*)(lds + SSD_B);
    __syncthreads();
    {   const bf16_t* BTg = (const bf16_t*)(p.ws + WS_BTT) + (size_t)(bc * SG + g) * BC_TILE;
#pragma unroll
        for (int k = 0; k < 4; ++k) { const int idx = tid + 512 * k, n = idx >> 4, j = idx & 15; *(LAS u32x4_t*)(BcT + n * SSTR + j * 8) = *(const u32x4_t*)(BTg + n * 128 + j * 8); } }
    dt_scan(p, b, c, h, w, lane, lds);
    LAS float* DT = (LAS float*)(lds + SSD_DT) + w * 128; LAS float* ACS = (LAS float*)(lds + SSD_ACS) + w * 128; LAS float* DTW = (LAS float*)(lds + SSD_DTW) + w * 128;
    const float aend = ACS[127];
    DTW[lane] = DT[lane] * __expf(aend - ACS[lane]); DTW[lane + 64] = DT[lane + 64] * __expf(aend - ACS[lane + 64]);
    if (lane == 0) ((float*)(p.ws + OFF_CD))[(b * 64 + c) * SH + h] = __expf(aend);
    LDS_WAIT();
    __syncthreads();
#pragma unroll 1
    for (int pt = 0; pt < 2; ++pt) {
        const bf16_t* xrow = (const bf16_t*)(p.ws + WS_XCT) + ((size_t)(bc * SH + h) * SP + pt * 32 + l31) * 128;
        f32x16 acc[4];
#pragma unroll
        for (int nt = 0; nt < 4; ++nt)
#pragma unroll
            for (int r = 0; r < 16; ++r) acc[nt][r] = 0.f;
#pragma unroll 4
        for (int ks = 0; ks < 8; ++ks) {
            const int lb = ks * 16 + 8 * half;
            const u32x4_t xr = *(const u32x4_t*)(xrow + lb);
            const f32x4_t d0 = *(const LAS f32x4_t*)(DTW + lb), d1 = *(const LAS f32x4_t*)(DTW + lb + 4);
            u32x4_t xs; xs.x = cvtpk(bf_lo(xr.x) * d0[0], bf_hi(xr.x) * d0[1]); xs.y = cvtpk(bf_lo(xr.y) * d0[2], bf_hi(xr.y) * d0[3]);
            xs.z = cvtpk(bf_lo(xr.z) * d1[0], bf_hi(xr.z) * d1[1]); xs.w = cvtpk(bf_lo(xr.w) * d1[2], bf_hi(xr.w) * d1[3]);
            const bf16x8 af = __builtin_bit_cast(bf16x8, xs);
#pragma unroll
            for (int nt = 0; nt < 4; ++nt) { const bf16x8 bfm = *(const LAS bf16x8*)(BcT + (nt * 32 + l31) * SSTR + lb); acc[nt] = MFMA32(af, bfm, acc[nt]); }
        }
        bf16_t* S = (bf16_t*)(p.ws + WS_SST) + ((size_t)(b * 64 + c) * SH + h) * (SP * SN);
#pragma unroll
        for (int nt = 0; nt < 4; ++nt)
#pragma unroll
            for (int r = 0; r < 16; r += 2) { const int pp = pt * 32 + (r & 3) + 8 * (r >> 2) + 4 * half; const unsigned cv = cvtpk(acc[nt][r], acc[nt][r + 1]);
                S[pp * SN + nt * 32 + l31] = (bf16_t)(cv & 0xffffu); S[(pp + 1) * SN + nt * 32 + l31] = (bf16_t)(cv >> 16); }
    }
}
DEVINL void ssd2_scan(const P& p, int gt) {
    const size_t e = (size_t)gt * 4; if (e >= 2 * S_CHUNK) return;
    const int b = (int)(e / S_CHUNK); const size_t rem = e % S_CHUNK; const int h = (int)(rem >> 13);
    const bf16_t* S = (const bf16_t*)(p.ws + WS_SST); bf16_t* PV = (bf16_t*)(p.ws + WS_PREV); const float* CD = (const float*)(p.ws + OFF_CD);
    float s0 = 0.f, s1 = 0.f, s2 = 0.f, s3 = 0.f;
#pragma unroll 8
    for (int c = 0; c < 64; ++c) {
        const size_t off = (size_t)(b * 64 + c) * S_CHUNK + rem;
        const uint2 v = *(const uint2*)(S + off); const float cd = CD[(b * 64 + c) * SH + h];
        s0 = s0 * cd + bf_lo(v.x); s1 = s1 * cd + bf_hi(v.x); s2 = s2 * cd + bf_lo(v.y); s3 = s3 * cd + bf_hi(v.y);
        *(uint2*)(PV + off) = make_uint2(cvtpk(s0, s1), cvtpk(s2, s3));
    }
}
DEVINL void ssd3_item(const P& p, int item, LAS unsigned char* lds, int tid, int w, int lane) {
    asm volatile("" : "+v"(tid)); asm volatile("" : "+s"(w)); lane = tid & 63;
    const int g = item & 3, c = ((item >> 2) & 63) + 1, b = item >> 8, h = g * 8 + w, half = lane >> 5, l31 = lane & 31, bc = b * NCH + c;
    LAS bf16_t* Bc = (LAS bf16_t*)(lds + SSD_B); LAS bf16_t* Cc = (LAS bf16_t*)(lds + SSD_C);
    __syncthreads();
    {   const size_t tile = (size_t)(bc * SG + g) * BC_TILE;
        const bf16_t* BCg = (const bf16_t*)(p.ws + WS_BCC) + tile; const bf16_t* CCg = (const bf16_t*)(p.ws + WS_CCC) + tile;
#pragma unroll
        for (int k = 0; k < 4; ++k) { const int idx = tid + 512 * k, l = idx >> 4, j = idx & 15;
            *(LAS u32x4_t*)(Bc + l * SSTR + j * 8) = *(const u32x4_t*)(BCg + l * 128 + j * 8);
            *(LAS u32x4_t*)(Cc + l * SSTR + j * 8) = *(const u32x4_t*)(CCg + l * 128 + j * 8); } }
    dt_scan(p, b, c, h, w, lane, lds);
    LAS float* DT = (LAS float*)(lds + SSD_DT) + w * 128; LAS float* ACS = (LAS float*)(lds + SSD_ACS) + w * 128;
    __syncthreads();
    const bf16_t* ZP = (const bf16_t*)(p.ws + WS_ZP);
    const bf16_t* PV = (const bf16_t*)(p.ws + WS_PREV) + ((size_t)(b * 64 + c - 1) * SH + h) * (SP * SN);
    const bf16_t* xrow = (const bf16_t*)(p.ws + WS_XCT) + ((size_t)(bc * SH + h) * SP + l31) * 128;
    const float dsk = p.in[9][h];
    f32x16 acc[2][4];
#pragma unroll
    for (int pt = 0; pt < 2; ++pt)
#pragma unroll
        for (int lt = 0; lt < 4; ++lt)
#pragma unroll
            for (int r = 0; r < 16; ++r) acc[pt][lt][r] = 0.f;
#pragma unroll 2
    for (int kn = 0; kn < 8; ++kn) {
        const int nb = kn * 16 + 8 * half;
        const bf16x8 a0 = *(const bf16x8*)(PV + (size_t)l31 * SN + nb), a1 = *(const bf16x8*)(PV + (size_t)(32 + l31) * SN + nb);
#pragma unroll
        for (int lt = 0; lt < 4; ++lt) { const bf16x8 cf = *(const LAS bf16x8*)(Cc + (lt * 32 + l31) * SSTR + nb); acc[0][lt] = MFMA32(a0, cf, acc[0][lt]); acc[1][lt] = MFMA32(a1, cf, acc[1][lt]); }
    }
#pragma unroll
    for (int lt = 0; lt < 4; ++lt) { const float ea = __expf(ACS[lt * 32 + l31]);
#pragma unroll
        for (int r = 0; r < 16; ++r) { acc[0][lt][r] *= ea; acc[1][lt][r] *= ea; } }
#pragma unroll 1
    for (int st = 0; st < 4; ++st) {
        int dd = l31 - 4 * half; asm volatile("" : "+v"(dd));
        bf16x8 xa[2][2];
#pragma unroll
        for (int pt = 0; pt < 2; ++pt)
#pragma unroll
            for (int ks = 0; ks < 2; ++ks) { const int s0 = st * 32 + 16 * ks + 4 * half;
                const u32x2_t x0 = *(const u32x2_t*)(xrow + pt * 32 * 128 + s0), x1 = *(const u32x2_t*)(xrow + pt * 32 * 128 + s0 + 8);
                xa[pt][ks] = __builtin_bit_cast(bf16x8, ((u32x4_t){x0.x, x0.y, x1.x, x1.y})); }
#pragma unroll
        for (int lt = 0; lt < 4; ++lt) { if (lt < st) continue;
            f32x16 ga;
#pragma unroll
            for (int r = 0; r < 16; ++r) ga[r] = 0.f;
#pragma unroll
            for (int kn = 0; kn < 8; ++kn) {
                const int nb = kn * 16 + 8 * half;
                const bf16x8 bfm = *(const LAS bf16x8*)(Bc + (st * 32 + l31) * SSTR + nb), cf = *(const LAS bf16x8*)(Cc + (lt * 32 + l31) * SSTR + nb);
                ga = MFMA32(bfm, cf, ga);
            }
            float mv[16]; const float acl = ACS[lt * 32 + l31];
#pragma unroll
            for (int q = 0; q < 4; ++q) { const f32x4_t a4 = *(const LAS f32x4_t*)(ACS + st * 32 + 8 * q + 4 * half), d4 = *(const LAS f32x4_t*)(DT + st * 32 + 8 * q + 4 * half);
#pragma unroll
                for (int i = 0; i < 4; ++i) { const int r = 4 * q + i;
                    float v = ga[r] * __expf(fminf(acl - a4[i], 0.f)) * d4[i];
                    if (lt == st) { v = (8 * q + i <= dd) ? v : 0.f; v += (8 * q + i == dd) ? dsk : 0.f; }
                    mv[r] = v; } }
            const bf16x8 b0 = pack8(mv), b1 = pack8(mv + 8);
            acc[0][lt] = MFMA32(xa[0][0], b0, acc[0][lt]); acc[1][lt] = MFMA32(xa[1][0], b0, acc[1][lt]);
            acc[0][lt] = MFMA32(xa[0][1], b1, acc[0][lt]); acc[1][lt] = MFMA32(xa[1][1], b1, acc[1][lt]);
        }
    }
    LAS bf16_t* ZT = (LAS bf16_t*)(lds + SSD_WV + w * SSD_WV_BYTES);
    const int rr = lane >> 2, cq = lane & 3;
    float ssq[4];
#pragma unroll
    for (int lt = 0; lt < 4; ++lt) ssq[lt] = 0.f;
#pragma unroll
    for (int pt = 0; pt < 2; ++pt) {
#pragma unroll
        for (int k0 = 0; k0 < 8; k0 += 4) {
            u32x4_t zl[4];
#pragma unroll
            for (int k = 0; k < 4; ++k) zl[k] = *(const u32x4_t*)(ZP + ((size_t)b * LP + 128 * c + rr + 16 * (k0 + k)) * NIN + C_Z + h * 64 + pt * 32 + cq * 8);
#pragma unroll
            for (int k = 0; k < 4; ++k) *(LAS u32x4_t*)(ZT + (rr + 16 * (k0 + k)) * 32 + cq * 8) = zl[k];
        }
        LDS_WAIT();
#pragma unroll
        for (int lt = 0; lt < 4; ++lt) {
            float sq = 0.f;
#pragma unroll
            for (int q = 0; q < 4; ++q) { const u32x2_t z4 = *(const LAS u32x2_t*)(ZT + (lt * 32 + l31) * 32 + 8 * q + 4 * half);
                const float y0 = acc[pt][lt][4 * q] * siluf(bf_lo(z4.x)), y1 = acc[pt][lt][4 * q + 1] * siluf(bf_hi(z4.x)), y2 = acc[pt][lt][4 * q + 2] * siluf(bf_lo(z4.y)), y3 = acc[pt][lt][4 * q + 3] * siluf(bf_hi(z4.y));
                acc[pt][lt][4 * q] = y0; acc[pt][lt][4 * q + 1] = y1; acc[pt][lt][4 * q + 2] = y2; acc[pt][lt][4 * q + 3] = y3;
                sq += (y0 * y0 + y1 * y1) + (y2 * y2 + y3 * y3); }
            ssq[lt] += sq;
        }
        LDS_WAIT();
    }
#pragma unroll
    for (int lt = 0; lt < 4; ++lt) ssq[lt] += __shfl_xor(ssq[lt], 32);
    LAS float* RED = (LAS float*)(lds + SSD_RED);
    if (half == 0) {
#pragma unroll
        for (int lt = 0; lt < 4; ++lt) RED[w * 128 + lt * 32 + l31] = ssq[lt];
    }
    LDS_WAIT();
    __syncthreads();
    float rstd[4];
#pragma unroll
    for (int lt = 0; lt < 4; ++lt) { float tot = 0.f;
#pragma unroll
        for (int ww = 0; ww < 8; ++ww) tot += RED[ww * 128 + lt * 32 + l31];
        rstd[lt] = 1.f / sqrtf(tot * (1.f / 512.f) + RMS_EPS); }
    const float* ng = p.in[10];
    bf16_t* AY = (bf16_t*)(p.ws + WS_AY);
#pragma unroll
    for (int pt = 0; pt < 2; ++pt) {
#pragma unroll
        for (int q = 0; q < 4; ++q) { const f32x4_t g4 = *(const f32x4_t*)(ng + h * 64 + pt * 32 + 8 * q + 4 * half);
#pragma unroll
            for (int lt = 0; lt < 4; ++lt)
                *(LAS u32x2_t*)(ZT + (lt * 32 + l31) * 32 + 8 * q + 4 * half) = (u32x2_t){cvtpk(acc[pt][lt][4 * q] * rstd[lt] * g4[0], acc[pt][lt][4 * q + 1] * rstd[lt] * g4[1]), cvtpk(acc[pt][lt][4 * q + 2] * rstd[lt] * g4[2], acc[pt][lt][4 * q + 3] * rstd[lt] * g4[3])}; }
        LDS_WAIT();
#pragma unroll
        for (int k = 0; k < 8; ++k) *(u32x4_t*)(AY + ((size_t)b * SEQ + 128 * (c - 1) + rr + 16 * k) * 3072 + 1024 + h * 64 + pt * 32 + cq * 8) = *(const LAS u32x4_t*)(ZT + (rr + 16 * k) * 32 + cq * 8);
        LDS_WAIT();
    }
}

constexpr int AT_KSTR = 72;
constexpr int AT_VSTR = 388;
constexpr int AT_K = 0, AT_V = 288 * AT_KSTR * 2;
DEVINL void attn_mfma_item(const P& p, int item, LAS unsigned char* lds, int tid, int w, int lane) {
    asm volatile("" : "+v"(tid)); asm volatile("" : "+s"(w)); lane = tid & 63;
    const int n = (item & 63) + 1, kvh = (item >> 6) & 3, b = item >> 8, half = lane >> 5, l31 = lane & 31;
    const bf16_t* ZP = (const bf16_t*)(p.ws + WS_ZP);
    LAS bf16_t* Kl = (LAS bf16_t*)(lds + AT_K); LAS bf16_t* Vt = (LAS bf16_t*)(lds + AT_V);
    __syncthreads();
    for (int ci = tid; ci < 288 * 8; ci += 512) {
        const int kk = ci >> 3, dc = ci & 7;
        u32x4_t kv = (u32x4_t){0u, 0u, 0u, 0u}, vv = (u32x4_t){0u, 0u, 0u, 0u};
        if (kk < 272) { const int pr = kk < 256 ? 128 * (n - 1) + kk : 112 + (kk - 256);
            const bf16_t* rp = ZP + ((size_t)b * LP + pr) * NIN + kvh * 64 + dc * 8;
            kv = *(const u32x4_t*)(rp + C_K); vv = *(const u32x4_t*)(rp + C_V); }
        *(LAS u32x4_t*)(Kl + kk * AT_KSTR + dc * 8) = kv;
        LAS bf16_t* vd = Vt + (dc * 8) * AT_VSTR + kk;
        vd[0] = (bf16_t)(vv.x & 0xffffu); vd[AT_VSTR] = (bf16_t)(vv.x >> 16); vd[2 * AT_VSTR] = (bf16_t)(vv.y & 0xffffu); vd[3 * AT_VSTR] = (bf16_t)(vv.y >> 16);
        vd[4 * AT_VSTR] = (bf16_t)(vv.z & 0xffffu); vd[5 * AT_VSTR] = (bf16_t)(vv.z >> 16); vd[6 * AT_VSTR] = (bf16_t)(vv.w & 0xffffu); vd[7 * AT_VSTR] = (bf16_t)(vv.w >> 16);
    }
    LDS_WAIT();
    __syncthreads();
    const int g = w >> 1, qh = w & 1, hq = kvh * 4 + g;
    const float sink = p.in[11][hq];
    bf16_t* AY = (bf16_t*)(p.ws + WS_AY);
#pragma unroll 1
    for (int q2 = 0; q2 < 2; ++q2) {
        const int qt = 2 * qh + q2;
        const bf16_t* qp = ZP + ((size_t)b * LP + 128 * n + 32 * qt + l31) * NIN + C_Q + hq * 64 + 8 * half;
        bf16x8 qf[4];
#pragma unroll
        for (int ks = 0; ks < 4; ++ks) qf[ks] = *(const bf16x8*)(qp + ks * 16);
        f32x16 o0, o1;
#pragma unroll
        for (int r = 0; r < 16; ++r) { o0[r] = 0.f; o1[r] = 0.f; }
        float m = sink, lsum = (half == 0) ? 1.f : 0.f;
        const int iq = 32 * qt + l31;
#pragma unroll 1
        for (int t = 0; t < 6; ++t) {
            const int jt = (t < 5) ? qt + t : 8;
            if (n == 1 && jt < 4) continue;
            f32x16 st;
#pragma unroll
            for (int r = 0; r < 16; ++r) st[r] = 0.f;
#pragma unroll
            for (int ks = 0; ks < 4; ++ks) { const bf16x8 kf = *(const LAS bf16x8*)(Kl + (jt * 32 + l31) * AT_KSTR + ks * 16 + 8 * half); st = MFMA32(kf, qf[ks], st); }
            float tmax = -1e30f;
#pragma unroll
            for (int r = 0; r < 16; ++r) { const int kk = jt * 32 + (r & 3) + 8 * (r >> 2) + 4 * half;
                const bool ok = (jt == 8) ? (kk < 272) : (kk >= iq + 1 && kk <= iq + 128);
                st[r] = ok ? st[r] * 0.125f : -1e30f; tmax = fmaxf(tmax, st[r]); }
            tmax = fmaxf(tmax, __shfl_xor(tmax, 32));
            const float mn = fmaxf(m, tmax), al = __expf(m - mn);
            float ps = 0.f; float pv[16];
#pragma unroll
            for (int r = 0; r < 16; ++r) { pv[r] = __expf(st[r] - mn); ps += pv[r]; }
            lsum = lsum * al + ps; m = mn;
#pragma unroll
            for (int r = 0; r < 16; ++r) { o0[r] *= al; o1[r] *= al; }
            const bf16x8 pb0 = pack8(pv), pb1 = pack8(pv + 8);
#pragma unroll
            for (int s2 = 0; s2 < 2; ++s2) {
                const LAS bf16_t* v0 = Vt + l31 * AT_VSTR + jt * 32 + 16 * s2 + 4 * half; const LAS bf16_t* v1 = v0 + 32 * AT_VSTR;
                const u32x2_t a00 = *(const LAS u32x2_t*)(v0), a01 = *(const LAS u32x2_t*)(v0 + 8), a10 = *(const LAS u32x2_t*)(v1), a11 = *(const LAS u32x2_t*)(v1 + 8);
                const u32x4_t A0 = (u32x4_t){a00.x, a00.y, a01.x, a01.y}, A1 = (u32x4_t){a10.x, a10.y, a11.x, a11.y};
                o0 = MFMA32(__builtin_bit_cast(bf16x8, A0), s2 == 0 ? pb0 : pb1, o0);
                o1 = MFMA32(__builtin_bit_cast(bf16x8, A1), s2 == 0 ? pb0 : pb1, o1);
            }
        }
        lsum += __shfl_xor(lsum, 32);
        const float il = 1.f / lsum;
        const size_t orow = ((size_t)b * SEQ + 128 * (n - 1) + 32 * qt + l31) * 3072 + hq * 64;
#pragma unroll
        for (int q = 0; q < 4; ++q) {
            *(uint2*)(AY + orow + 8 * q + 4 * half) = make_uint2(cvtpk(o0[4 * q] * il, o0[4 * q + 1] * il), cvtpk(o0[4 * q + 2] * il, o0[4 * q + 3] * il));
            *(uint2*)(AY + orow + 32 + 8 * q + 4 * half) = make_uint2(cvtpk(o1[4 * q] * il, o1[4 * q + 1] * il), cvtpk(o1[4 * q + 2] * il, o1[4 * q + 3] * il));
        }
    }
}

constexpr int LDS_BYTES = 163840, CTLZ_OFF = LDS_BYTES - 1024, MISC_OFF = CTLZ_OFF + 320;
static_assert(SSD_WV + 8 * SSD_WV_BYTES <= CTLZ_OFF && AT_V + 64 * AT_VSTR * 2 <= CTLZ_OFF && pg8::STAGE_BYTES <= CTLZ_OFF, "LDS map");
constexpr int NPHASE = 11;
__global__ void __launch_bounds__(512, 2) mega_fwd(P p) {
    extern __shared__ __attribute__((aligned(16))) unsigned char lds_raw[];
    LAS unsigned char* lds = (LAS unsigned char*)lds_raw;
    volatile LAS unsigned* MISC = (volatile LAS unsigned*)(lds + MISC_OFF);
    const int tid = threadIdx.x, lane = tid & 63, wave = __builtin_amdgcn_readfirstlane(tid >> 6);
    const int G = gridDim.x, bx = blockIdx.x;
    const int vcu = (G % 8 == 0) ? (bx % 8) * (G / 8) + bx / 8 : bx;
    const int gw = bx * 8 + wave, NGW = G * 8;
    unsigned char* ws = p.ws;
    for (int u = tid; u < (LDS_BYTES - CTLZ_OFF) / 4; u += 512) ((LAS unsigned*)(lds + CTLZ_OFF))[u] = 0u;
    __syncthreads();
    const bool one_launch = (p.ph_hi - p.ph_lo) > 1;
    XcdBarrier bar; bar.bar = (unsigned*)(ws + WS_CTL); bar.x = 0; bar.st = nullptr;
    if (one_launch) bar = xcd_barrier_post((unsigned*)(ws + WS_CTL), MISC + 8);
#ifndef PHASE_MASK
#define PHASE_MASK 0xFFFF
#endif
#define IN(k) (((PHASE_MASK >> (k)) & 1) && p.ph_lo <= (k) && (k) < p.ph_hi)
#define SEAM(k) do { if (IN(k) && IN((k) + 1)) xcd_barrier(bar); } while (0)
#define REP(k) for (int rep_ = 0; rep_ < 1 + ((REPEAT_MASK >> (k)) & 1); ++rep_, (void)((rep_ < 1 + ((REPEAT_MASK >> (k)) & 1)) ? (xcd_barrier(bar), 0) : 0))

    if (IN(0)) REP(0) {
        {   constexpr int NDENSE_ITEMS = 32 * 344 + 16 * 64 + 32 * 64 + 32 * 64;
            const int niter = (MP + NGW - 1) / NGW, tpw = (NDENSE_ITEMS + NGW - 1) / NGW, tpi = (tpw + niter - 1) / niter;
            for (int i = 0; i < niter; ++i) {
                const int R = gw + i * NGW; if (R < MP) ln0_row(p, R, lane);
                phase_weights(p, (LAS float*)(lds + wave * 16384), gw, NGW, lane, false, i * tpi * NGW, (i + 1) * tpi * NGW);
            } }
        for (int idx = bx * 512 + tid; idx < DM * NE; idx += G * 512) { const int i = idx >> 6, cc = idx & 63; ((float*)(ws + OFF_WREG))[((cc >> 3) * DM + i) * 8 + (cc & 7)] = p.in[19][idx]; }
    }
    SEAM(0);
    for (int eb_ = 0; eb_ < EXTRA_BARRIERS; ++eb_) xcd_barrier(bar);
    if (IN(1)) REP(1) {
        pg8::Gemm g{(const bf16_t*)(ws + WS_H0), (const bf16_t*)(ws + WS_WIN), DM, DM, DM};
        pg8::StaticOrder S; S.init(g, MP, NIN, G, bx, WGM_INPROJ);
        pg8::EpiBf16Plain E{(bf16_t*)(ws + WS_ZP), (size_t)NIN};
        pg8::gemm_phase<pg8::EpiBf16Plain, pg8::StaticOrder, true, false>(lds, g, S, E);
    }
    SEAM(1);
    if (IN(2)) REP(2) {
        for (int pc = gw; pc < 256; pc += NGW) conv_c64_piece(p, pc, lds, wave, lane);
        for (int j = vcu; j < 512; j += G) {
            conv_pre_item(p, j >> 8, (j >> 2) & 63, j & 3, lds, tid, wave, lane);
            ssd1_item(p, j, lds, tid, wave, lane);
        }
        for (int it = vcu; it < 512; it += G) attn_mfma_item(p, it, lds, tid, wave, lane);
    }
    SEAM(2);
    if (IN(3)) REP(3) { for (int gt = bx * 512 + tid; gt < (int)(2 * S_CHUNK / 4); gt += G * 512) ssd2_scan(p, gt); }
    SEAM(3);
    if (IN(4)) REP(4) { for (int it = vcu; it < 512; it += G) ssd3_item(p, it, lds, tid, wave, lane); }
    SEAM(4);
    if (IN(5)) {
        {   pg8::Gemm g{(const bf16_t*)(ws + WS_AY), (const bf16_t*)(ws + WS_WBRA), 3072, 1024, 1024};
            pg8::StaticOrder S; S.init(g, MR, DM, G, bx, WGM_DENSE);
            pg8::EpiBrA E{(bf16_t*)(ws + WS_T1S), (const bf16_t*)(ws + WS_ZP)};
            pg8::gemm_phase<pg8::EpiBrA, pg8::StaticOrder, true, false>(lds, g, S, E); }
        {   pg8::Gemm g{(const bf16_t*)(ws + WS_AY) + 1024, (const bf16_t*)(ws + WS_WBRS), 3072, DM, DM};
            pg8::StaticOrder S; S.init(g, MR, DM, G, bx, WGM_DENSE);
            pg8::EpiBrS E{(const bf16_t*)(ws + WS_T1S), (const bf16_t*)(ws + WS_ZP), (bf16_t*)(ws + WS_MERGED)};
            pg8::gemm_phase<pg8::EpiBrS, pg8::StaticOrder, true, false>(lds, g, S, E); }
    }
    SEAM(5);
    if (IN(6)) {
        pg8::Gemm g{(const bf16_t*)(ws + WS_MERGED), (const bf16_t*)(ws + WS_WO), DM, DM, DM};
        pg8::StaticOrder S; S.init(g, MR, DM, G, bx, WGM_DENSE);
        pg8::EpiWo E{(float*)(ws + WS_U), p.in[0], (const float*)(ws + OFF_ROWSTAT), p.in[2], p.in[3]};
        pg8::gemm_phase<pg8::EpiWo, pg8::StaticOrder, true, false>(lds, g, S, E);
    }
    SEAM(6);
    if (IN(7)) {
        LAS float* wrgl = (LAS float*)(lds + 8 * 8448);
        __syncthreads();
        for (int u = tid; u < DM * 8 / 4; u += 512) *(LAS pg8::f32x4*)(wrgl + 4 * u) = *(const pg8::f32x4*)(p.in[17] + 4 * u);
        LDS_WAIT(); __syncthreads();
        {   const int niter = (MR + NGW - 1) / NGW;
            LAS int* res = (LAS int*)(lds + 8 * 8448 + DM * 8 * 4);
            float4 vin[8];
            if (gw < MR) {
#pragma unroll
                for (int j = 0; j < 8; ++j) vin[j] = ((const float4*)((const float*)(ws + WS_U) + (size_t)gw * DM))[lane + 64 * j]; }
            for (int i = 0; i < niter; ++i) {
                const int r = gw + i * NGW, rn = (i + 1 < niter && r + NGW < MR) ? r + NGW : -1;
                if (r < MR) ln1_router_row<true>(p, r, rn, vin, lane, (LAS float*)(lds + wave * 8448), wrgl, res + (wave * niter + i) * 4);
#if !MOE_WF32
                { constexpr int NMOE_ITEMS = 64 * 32 * 32 + 64 * 8 * 64; const int tpw = (NMOE_ITEMS + NGW - 1) / NGW, tpi = (tpw + niter - 1) / niter;
                  phase_weights(p, (LAS float*)(lds + wave * 8448), gw, NGW, lane, true, i * tpi * NGW, (i + 1) * tpi * NGW); }
#endif
            }
            LAS int* lcnt = (LAS int*)lds; LAS int* lbase = lcnt + 64; LAS int* lp = lcnt + 128;
            int* cnt = (int*)(ws + OFF_CNT); int* list_ent = (int*)(ws + WS_LIST); float* list_w = (float*)(ws + WS_LISTW);
            LDS_WAIT(); __syncthreads();
            if (tid < 64) lcnt[tid] = 0;
            LDS_WAIT(); __syncthreads();
            const int nent = 16 * niter;
            for (int t = tid; t < nent; t += 512) { const int w = t / (2 * niter), i = (t >> 1) % niter, k = t & 1, r = bx * 8 + w + i * NGW;
                if (r < MR) lp[t] = __hip_atomic_fetch_add(lcnt + res[(w * niter + i) * 4 + k], 1, __ATOMIC_RELAXED, __HIP_MEMORY_SCOPE_WORKGROUP); }
            LDS_WAIT(); __syncthreads();
            if (tid < 64) { const int c = lcnt[tid]; lbase[tid] = c ? atomicAdd(&cnt[tid], c) : 0; }
            LDS_WAIT(); __syncthreads();
            for (int t = tid; t < nent; t += 512) { const int w = t / (2 * niter), i = (t >> 1) % niter, k = t & 1, r = bx * 8 + w + i * NGW;
                if (r < MR) { const int e = res[(w * niter + i) * 4 + k], pos = lbase[e] + lp[t];
                    list_ent[e * MR + pos] = r * 2 + k; list_w[e * MR + pos] = __int_as_float(res[(w * niter + i) * 4 + 2 + k]); } }
        }
    }
    SEAM(7);
    LAS int* tl_e = (LAS int*)(lds + 131072); LAS int* tl_f = tl_e + MOE_MAXT; LAS int* tl_n = tl_f + MOE_MAXT; LAS int* tl_x = tl_n + MOE_MAXT;
    if (IN(8) || IN(9)) {
        __syncthreads();
        if (tid < NE) tl_x[tid] = (((const int*)(ws + OFF_CNT))[tid] + MOE_TILE - 1) / MOE_TILE;
        LDS_WAIT(); __syncthreads();
        if (tid < NE) { int st0 = 0; for (int i = 0; i < tid; ++i) st0 += tl_x[i];
            const int cn = ((const int*)(ws + OFF_CNT))[tid], nt = tl_x[tid];
            for (int j = 0; j < nt; ++j) { tl_e[st0 + j] = tid; tl_f[st0 + j] = j * MOE_TILE; tl_n[st0 + j] = (cn - j * MOE_TILE) < MOE_TILE ? (cn - j * MOE_TILE) : MOE_TILE; }
            if (tid == NE - 1) tl_x[64] = st0 + nt; }
        LDS_WAIT(); __syncthreads();
    }
    const pg8::MoeTiles MT{tl_e, tl_f, tl_n, (const int*)(ws + WS_LIST), (const float*)(ws + WS_LISTW)};
    if (IN(8)) REP(8) {
        const int NT = tl_x[64];
        pg8::Gemm g{(const bf16_t*)(ws + WS_H1B), (const bf16_t*)(ws + WS_WGU), DM, DM, DM};
        pg8::MoeOrder S{4, NT * 4, G, vcu, g.A, DM, g.Bt, (size_t)1024 * DM, DM, MT, true};
        pg8::EpiGateUp E{(bf16_t*)(ws + WS_HID)};
#if MOE_WF32
        const pg8::WF32 wf{p.in[21], p.in[22], (size_t)DM * DE, 128, DE};
        pg8::gemm_phase_wf32<pg8::EpiGateUp, pg8::MoeOrder, true, WF32_ROWMAP_GU>(lds, g, S, E, wf);
#else
        pg8::gemm_phase<pg8::EpiGateUp, pg8::MoeOrder, true, true>(lds, g, S, E);
#endif
    }
#if PROBE_P8_TWICE
    xcd_barrier(bar);
    if (IN(8)) {
        const int NT = tl_x[64];
        pg8::Gemm g{(const bf16_t*)(ws + WS_H1B), (const bf16_t*)(ws + WS_WGU), DM, DM, DM};
        pg8::MoeOrder S{4, NT * 4, G, vcu, g.A, DM, g.Bt, (size_t)1024 * DM, DM, MT, true};
        pg8::EpiGateUp E{(bf16_t*)(ws + WS_HID)};
#if MOE_WF32
        const pg8::WF32 wf{p.in[21], p.in[22], (size_t)DM * DE, 128, DE};
        pg8::gemm_phase_wf32<pg8::EpiGateUp, pg8::MoeOrder, true, WF32_ROWMAP_GU>(lds, g, S, E, wf);
#else
        pg8::gemm_phase<pg8::EpiGateUp, pg8::MoeOrder, true, true>(lds, g, S, E);
#endif
    }
#endif
    SEAM(8);
    if (IN(9)) REP(9) {
        const int NT = tl_x[64];
        pg8::Gemm g{(const bf16_t*)(ws + WS_HID), (const bf16_t*)(ws + WS_WDN), DE, DE, DE};
        pg8::MoeOrder S{8, NT * 8, G, vcu, g.A, DE, g.Bt, (size_t)DM * DE, DE, MT, false};
        pg8::EpiDown E{(bf16_t*)(ws + WS_Y), MT};
#if MOE_WF32
        const pg8::WF32 wf{p.in[23], p.in[23] + 128, (size_t)DE * DM, 256, DM};
        pg8::gemm_phase_wf32<pg8::EpiDown, pg8::MoeOrder, false, WF32_ROWMAP_DN>(lds, g, S, E, wf);
#else
        pg8::gemm_phase<pg8::EpiDown, pg8::MoeOrder, true, false>(lds, g, S, E);
#endif
    }
    SEAM(9);
    if (IN(10)) REP(10) { for (int r = gw; r < MR; r += NGW) ln2_row(p, r, lane); }
#undef IN
#undef SEAM
}

extern "C" void kernel_launch(void* const* d_in, const int* in_sizes, int n_in, void* d_out, int out_size, void* d_ws, size_t ws_size, hipStream_t stream) {
    static int grid = 0;
    if (grid == 0) {
        if (n_in != 26 || ws_size < WS_END) { fprintf(stderr, "kernel_launch: unexpected n_in %d or ws_size %zu\n", n_in, ws_size); grid = -1; return; }
        int dev = 0, cus = 0;
        if (hipGetDevice(&dev) != hipSuccess || hipDeviceGetAttribute(&cus, hipDeviceAttributeMultiprocessorCount, dev) != hipSuccess) { grid = -1; return; }
        if (hipFuncSetAttribute((const void*)mega_fwd, hipFuncAttributeMaxDynamicSharedMemorySize, LDS_BYTES) != hipSuccess) { fprintf(stderr, "kernel_launch: hipFuncSetAttribute failed\n"); grid = -1; return; }
        grid = cus;
    }
    if (grid < 0) return;
    (void)hipMemsetAsync((char*)d_ws + WS_CTL, 0, CTL_BYTES, stream);
    P a{};
    for (int i = 0; i < 26; ++i) a.in[i] = (const float*)d_in[i];
    a.out = (float*)d_out; a.ws = (unsigned char*)d_ws;
#if MK_PER_PHASE
    for (int k = 0; k < NPHASE; ++k) { a.ph_lo = k; a.ph_hi = k + 1; hipLaunchKernelGGL(mega_fwd, dim3(grid), dim3(512), LDS_BYTES, stream, a); }
#else
    a.ph_lo = 0; a.ph_hi = NPHASE;
    hipLaunchKernelGGL(mega_fwd, dim3(grid), dim3(512), LDS_BYTES, stream, a);
#endif
}
```

```cpp
#include <hip/hip_runtime.h>
#include <stdint.h>
#include <stdio.h>

typedef unsigned short bf16_t;
typedef short bf16x8 __attribute__((ext_vector_type(8)));
typedef float f32x16 __attribute__((ext_vector_type(16)));
#define DEVINL __device__ __forceinline__
#define LAS __attribute__((address_space(3)))
#define WGM_INPROJ 4
#define WGM_DENSE 4
#define MOE_WF32 1
#define WF32_ROWMAP_GU 7
#define WF32_ROWMAP_DN 7
#define PROBE_P8_TWICE 0
#define REPEAT_MASK 0
#define EXTRA_BARRIERS 0
#ifndef MK_PER_PHASE
#define MK_PER_PHASE 0
#endif

constexpr int BATCH = 2, SEQ = 8192, DM = 2048, NMETA = 16;
constexpr int LP = 8320;
constexpr int MP = BATCH * LP;
constexpr int MR = BATCH * SEQ;
constexpr int NIN = 11008;
constexpr int C_Q = 0, C_K = 1024, C_V = 1280, C_Z = 1536, C_X = 3584, C_B = 5632, C_C = 6144, C_GA = 6656, C_GS = 8704, C_DT = 10752;
constexpr int HQ = 16, HKV = 4, HD = 64;
constexpr int SH = 32, SP = 64, SG = 4, SN = 128;
constexpr int NE = 64, DE = 512;
constexpr int MOE_TILE = 256, MOE_MAXT = 192, MOE_MAXPOS = MOE_MAXT * MOE_TILE;
constexpr float LN_EPS = 1e-5f, RMS_EPS = 1e-5f;
constexpr float ALPHA = 1.189207115002721f;

constexpr size_t MiB = 1ull << 20;
constexpr size_t WS_CTL = 0;
constexpr size_t CTL_BYTES = 1 * MiB;
constexpr size_t OFF_CNT = 64 * 1024;
constexpr size_t OFF_SS = 128 * 1024;
constexpr size_t WS_MISC = 1 * MiB;
constexpr size_t OFF_ROWSTAT = WS_MISC;
constexpr size_t OFF_ROWSTAT1 = WS_MISC + 128 * 1024;
constexpr size_t OFF_TILE_E = WS_MISC + 256 * 1024;
constexpr size_t OFF_WREG = WS_MISC + 512 * 1024;
constexpr size_t OFF_NT = WS_MISC + 260 * 1024;
constexpr size_t OFF_CD = WS_MISC + 264 * 1024;
constexpr size_t WS_WIN = 2 * MiB;
constexpr size_t WS_WBRA = 45 * MiB;
constexpr size_t WS_WBRS = 49 * MiB;
constexpr size_t WS_WO = 57 * MiB;
constexpr size_t WS_WGU = 65 * MiB;
constexpr size_t WS_WDN = 321 * MiB;
constexpr size_t WS_XCT = 65 * MiB;
constexpr size_t WS_BCC = 130 * MiB;
constexpr size_t WS_CCC = 147 * MiB;
constexpr size_t WS_BTT = 164 * MiB;
constexpr size_t WS_H0 = 449 * MiB;
constexpr size_t WS_T1S = 449 * MiB;
constexpr size_t WS_SST = 449 * MiB;
constexpr size_t WS_PREV = 960 * MiB;
constexpr size_t WS_ZP = 514 * MiB;
constexpr size_t WS_U = 514 * MiB;
constexpr size_t WS_H1 = 642 * MiB;
constexpr size_t WS_H1B = 770 * MiB;
constexpr size_t WS_LIST = 834 * MiB;
constexpr size_t WS_LISTW = 838 * MiB;
constexpr size_t WS_POS = 842 * MiB;
constexpr size_t WS_HID = 844 * MiB;
constexpr size_t WS_AY = 864 * MiB;
constexpr size_t WS_MERGED = 960 * MiB;
constexpr size_t WS_Y = 892 * MiB;
constexpr size_t WS_END = 1024 * MiB;

DEVINL float bf2f(bf16_t h) { return __uint_as_float(((unsigned)h) << 16); }
typedef __bf16 bf16x2_t __attribute__((ext_vector_type(2)));
typedef float f32x2_t __attribute__((ext_vector_type(2)));
DEVINL unsigned cvtpk(float lo, float hi) { f32x2_t v = {lo, hi}; bf16x2_t b = __builtin_convertvector(v, bf16x2_t); return __builtin_bit_cast(unsigned, b); }
DEVINL unsigned pk2(float lo, float hi) { return cvtpk(lo, hi); }
DEVINL bf16_t f2bf(float f) { return (bf16_t)(cvtpk(f, 0.f) & 0xffffu); }
DEVINL float bf_lo(unsigned w) { return __uint_as_float(w << 16); }
DEVINL float bf_hi(unsigned w) { return __uint_as_float(w & 0xffff0000u); }
DEVINL float wave_sum(float v) {
#pragma unroll
    for (int o = 1; o < 64; o <<= 1) v += __shfl_xor(v, o);
    return v;
}
DEVINL float sigmoidf(float x) { return __builtin_amdgcn_rcpf(1.f + __builtin_amdgcn_exp2f(-1.4426950408889634f * x)); }
DEVINL float siluf(float x) { return x * __builtin_amdgcn_rcpf(1.f + __builtin_amdgcn_exp2f(-1.4426950408889634f * x)); }
DEVINL int prow_of(int r) { return (r >> 13) * LP + 128 + (r & (SEQ - 1)); }
#define LDS_WAIT() asm volatile("s_waitcnt lgkmcnt(0)" ::: "memory")

namespace pg8 {
#define PG8_LAS __attribute__((address_space(3)))
typedef float f32x4 __attribute__((ext_vector_type(4)));
typedef unsigned u32x4 __attribute__((ext_vector_type(4)));
typedef unsigned u32x2 __attribute__((ext_vector_type(2)));
constexpr int BM = 256, BK = 64, HALF = 128, HTB = HALF * BK * 2, STAGE_BYTES = 8 * HTB, NXCD = 8, WGM = 8;
__host__ __device__ __forceinline__ int lds_byte(int r, int c) { const int st = (r >> 4) * 2 + (c >> 5), rr = r & 15, cc = c & 31, ob = rr * 64 + cc * 2; return st * 1024 + (ob ^ (((ob >> 9) & 1) << 5)); }
__host__ __device__ __forceinline__ void stage_rc(int b, int& R, int& C) { const int st = b / 1024, sb = b % 1024, swz = sb ^ (((sb >> 9) & 1) << 5); R = (st >> 1) * 16 + swz / 64; C = (st & 1) * 32 + (swz % 64) / 2; }
__host__ __device__ __forceinline__ int perm32(int rho) { const int n = rho >> 4, i = rho & 15; return 8 * (i >> 2) + 4 * n + (i & 3); }
struct Unit { int pm, pn; };
struct Gemm { const bf16_t* A; const bf16_t* Bt; int lda, ldb, K; };

struct StaticOrder {
    int nM, nN, nwg, G, c, wgm; const bf16_t* A; const bf16_t* Bt; int lda, ldb;
    __device__ void init(const Gemm& g, int M, int N, int G_, int c_, int wgm_ = WGM) { nM = M / BM; nN = N / BM; nwg = nM * nN; G = G_; c = c_; wgm = wgm_; A = g.A; Bt = g.Bt; lda = g.lda; ldb = g.ldb; }
    __device__ bool next(int i, Unit& u) const {
        const long L = (long)i * G + c; if (L >= nwg) return false;
        int wgid = (int)L; { const int q = nwg / NXCD, r = nwg % NXCD, xcd = wgid % NXCD, off = wgid / NXCD; wgid = (xcd < r ? xcd * (q + 1) : r * (q + 1) + (xcd - r) * q) + off; }
        const int nig = wgm * nN, gid = wgid / nig, fm = gid * wgm, gsz = (nM - fm) < wgm ? (nM - fm) : wgm;
        u.pm = fm + ((wgid % nig) % gsz); u.pn = (wgid % nig) / gsz; return true;
    }
    __device__ __forceinline__ const char* a_base(const Unit& u) const { return (const char*)(A + (size_t)u.pm * BM * lda); }
    __device__ __forceinline__ const char* b_base(const Unit& u) const { return (const char*)(Bt + (size_t)u.pn * BM * ldb); }
    __device__ __forceinline__ int a_row(const Unit&, int r) const { return r; }
    __device__ __forceinline__ bool half(const Unit&) const { return false; }
};
__device__ __forceinline__ unsigned cvt_pk_bf16(float lo, float hi) { unsigned r; asm volatile("v_cvt_pk_bf16_f32 %0, %1, %2" : "=v"(r) : "v"(lo), "v"(hi)); return r; }

template <class Epi, class Sched, bool ALIGN_EPI, bool GATHER>
__device__ __forceinline__ void gemm_phase(PG8_LAS unsigned char* lds, const Gemm g, const Sched& S, const Epi& E) {
    const int tid = threadIdx.x, wid = __builtin_amdgcn_readfirstlane(tid >> 6), lane = tid & 63, wr = wid >> 2, wc = wid & 3, fr = lane & 15, fq = lane >> 4;
    const int K = g.K, nt = K / BK;
    unsigned voffA[2][2], voffB[2]; int RA[2], CA[2];
#pragma unroll
    for (int i = 0; i < 2; ++i) { int R, C; stage_rc(tid * 16 + i * 8192, R, C); const int Rb = Epi::PERM ? ((R & ~31) + perm32(R & 31)) : R;
        RA[i] = R; CA[i] = C; voffA[0][i] = (unsigned)(R * g.lda + C) * 2u; voffA[1][i] = (unsigned)((R + HALF) * g.lda + C) * 2u; voffB[i] = (unsigned)(Rb * g.ldb + C) * 2u; }
    const size_t kstep = (size_t)(BK * 2);
    const size_t hstepB = (size_t)HALF * g.ldb * 2;
    const unsigned ldsw = (unsigned)wid * 1024u;
    const int aoff = lds_byte(wr * 64 + fr, fq * 8), boff = lds_byte(wc * 32 + fr, fq * 8);
#define PG8_SA(b, h) (((b) * 2 + (h)) * HTB)
#define PG8_SB(b, h) ((4 + (b) * 2 + (h)) * HTB)
#define PG8_STAGE(bufoff, gbase, voff) do { _Pragma("unroll") for (int _i = 0; _i < 2; ++_i) \
        __builtin_amdgcn_global_load_lds((const unsigned*)((const char*)(gbase) + (voff)[_i]), (PG8_LAS unsigned*)(lds + (bufoff) + ldsw + _i * 8192), 16, 0, 0); } while (0)
#define PG8_LDA(dst, b, h) do { _Pragma("unroll") for (int m = 0; m < 4; ++m) _Pragma("unroll") for (int k = 0; k < 2; ++k) dst[m][k] = *(const PG8_LAS bf16x8*)(lds + PG8_SA(b, h) + aoff + m * 2048 + k * 1024); } while (0)
#define PG8_LDB(dst, b, h) do { _Pragma("unroll") for (int n = 0; n < 2; ++n) _Pragma("unroll") for (int k = 0; k < 2; ++k) dst[n][k] = *(const PG8_LAS bf16x8*)(lds + PG8_SB(b, h) + boff + n * 2048 + k * 1024); } while (0)
#define PG8_MMA(ai, bj, At, Bt) do { __builtin_amdgcn_s_setprio(1); _Pragma("unroll") for (int m = 0; m < 4; ++m) _Pragma("unroll") for (int n = 0; n < 2; ++n) _Pragma("unroll") for (int k = 0; k < 2; ++k) \
        acc[ai][bj][m][n] = __builtin_amdgcn_mfma_f32_16x16x32_bf16(Bt[n][k], At[m][k], acc[ai][bj][m][n], 0, 0, 0); __builtin_amdgcn_s_setprio(0); } while (0)
#define PG8_WAIT_V(n) asm volatile("s_waitcnt vmcnt(" #n ")" ::: "memory")
#define PG8_WAIT_L(n) asm volatile("s_waitcnt lgkmcnt(" #n ")" ::: "memory")
#define PG8_BAR __builtin_amdgcn_s_barrier()
#define PG8_SCHED __builtin_amdgcn_sched_barrier(0)
#define PG8_GVOFF(u, vo) do { if constexpr (GATHER) { _Pragma("unroll") for (int _h = 0; _h < 2; ++_h) _Pragma("unroll") for (int _i = 0; _i < 2; ++_i) \
        vo[_h][_i] = (unsigned)(S.a_row(u, _h * HALF + RA[_i]) * g.lda + CA[_i]) * 2u; } } while (0)
    Unit cur, nxt; int ui = 0;
    if (!S.next(0, cur)) return;
    f32x4 acc[2][2][4][2];
#pragma unroll
    for (int a = 0; a < 2; ++a)
#pragma unroll
        for (int b = 0; b < 2; ++b)
#pragma unroll
            for (int m = 0; m < 4; ++m)
#pragma unroll
                for (int n = 0; n < 2; ++n) acc[a][b][m][n] = (f32x4){0.f, 0.f, 0.f, 0.f};
    bf16x8 At[4][2], B0[2][2], B1[2][2];
    unsigned nvoffA[2][2];
    PG8_GVOFF(cur, voffA);
    const char* cA = S.a_base(cur); const char* cB = S.b_base(cur);
    PG8_STAGE(PG8_SB(0, 0), cB, voffB); PG8_STAGE(PG8_SB(0, 1), cB + hstepB, voffB); PG8_STAGE(PG8_SA(0, 0), cA, voffA[0]); PG8_STAGE(PG8_SA(0, 1), cA, voffA[1]);
    if (wr == 1) PG8_BAR;
    PG8_WAIT_V(2); PG8_BAR;
    PG8_STAGE(PG8_SB(1, 0), cB + kstep, voffB); PG8_STAGE(PG8_SA(1, 0), cA + kstep, voffA[0]); PG8_STAGE(PG8_SB(1, 1), cB + hstepB + kstep, voffB);
    PG8_WAIT_V(6); PG8_BAR;
    for (;;) {
        const bool has_next = S.next(ui + 1, nxt);
        const bool hf = S.half(cur);
        const char* nA = has_next ? S.a_base(nxt) : cA; const char* nB = has_next ? S.b_base(nxt) : cB;
        if constexpr (GATHER) { if (has_next) { PG8_GVOFF(nxt, nvoffA); } else {
#pragma unroll
            for (int _h = 0; _h < 2; ++_h)
#pragma unroll
                for (int _i = 0; _i < 2; ++_i) nvoffA[_h][_i] = voffA[_h][_i]; } }
        for (int t = 0; t < nt; t += 2) {
            const bool last = (t == nt - 2);
            const char* a1 = cA + (size_t)(t + 1) * kstep;
            const char* a2 = last ? nA : cA + (size_t)(t + 2) * kstep; const char* b2 = last ? nB : cB + (size_t)(t + 2) * kstep;
            const char* a3 = a2 + kstep; const char* b3 = b2 + kstep;
            unsigned va0[2], va1[2];
            if constexpr (GATHER) { va0[0] = last ? nvoffA[0][0] : voffA[0][0]; va0[1] = last ? nvoffA[0][1] : voffA[0][1]; va1[0] = last ? nvoffA[1][0] : voffA[1][0]; va1[1] = last ? nvoffA[1][1] : voffA[1][1]; }
            else { va0[0] = voffA[0][0]; va0[1] = voffA[0][1]; va1[0] = voffA[1][0]; va1[1] = voffA[1][1]; }
            PG8_LDB(B0, 0, 0); PG8_LDB(B1, 0, 1); PG8_SCHED; PG8_LDA(At, 0, 0); PG8_STAGE(PG8_SA(1, 1), a1, voffA[1]);
            PG8_WAIT_V(8); PG8_WAIT_L(0); PG8_BAR; PG8_MMA(0, 0, At, B0); PG8_MMA(0, 1, At, B1); PG8_BAR; PG8_SCHED;
            PG8_LDA(At, 0, 1); PG8_STAGE(PG8_SB(0, 0), b2, voffB); PG8_STAGE(PG8_SB(0, 1), b2 + hstepB, voffB); PG8_STAGE(PG8_SA(0, 0), a2, va0);
            PG8_WAIT_V(8); PG8_WAIT_L(0); PG8_BAR; if (!hf) { PG8_MMA(1, 0, At, B0); PG8_MMA(1, 1, At, B1); } PG8_BAR; PG8_SCHED;
            PG8_LDB(B0, 1, 0); PG8_LDB(B1, 1, 1); PG8_SCHED; PG8_LDA(At, 1, 0); PG8_STAGE(PG8_SA(0, 1), a2, va1);
            PG8_WAIT_V(8); PG8_WAIT_L(0); PG8_BAR; PG8_MMA(0, 0, At, B0); PG8_MMA(0, 1, At, B1); PG8_BAR; PG8_SCHED;
            PG8_LDA(At, 1, 1); PG8_STAGE(PG8_SB(1, 0), b3, voffB); PG8_STAGE(PG8_SB(1, 1), b3 + hstepB, voffB); PG8_STAGE(PG8_SA(1, 0), a3, va0);
            PG8_WAIT_V(8); PG8_WAIT_L(0); PG8_BAR; if (!hf) { PG8_MMA(1, 0, At, B0); PG8_MMA(1, 1, At, B1); } PG8_BAR; PG8_SCHED;
        }
        if constexpr (ALIGN_EPI) { if (wr == 0) PG8_BAR; }
        E(acc, cur, wr, wc, fr, fq);
        if (!has_next) break;
#pragma unroll
        for (int a = 0; a < 2; ++a)
#pragma unroll
            for (int b = 0; b < 2; ++b)
#pragma unroll
                for (int m = 0; m < 4; ++m)
#pragma unroll
                    for (int n = 0; n < 2; ++n) acc[a][b][m][n] = (f32x4){0.f, 0.f, 0.f, 0.f};
        cur = nxt; cA = nA; cB = nB; ++ui;
        if constexpr (GATHER) {
#pragma unroll
            for (int _h = 0; _h < 2; ++_h)
#pragma unroll
                for (int _i = 0; _i < 2; ++_i) voffA[_h][_i] = nvoffA[_h][_i]; }
        if constexpr (ALIGN_EPI) { if (wr == 1) PG8_BAR; }
    }
    PG8_WAIT_V(0);
    if constexpr (!ALIGN_EPI) { if (wr == 0) PG8_BAR; }
    PG8_BAR;
#undef PG8_SA
#undef PG8_SB
#undef PG8_STAGE
#undef PG8_LDA
#undef PG8_LDB
#undef PG8_MMA
#undef PG8_WAIT_V
#undef PG8_WAIT_L
#undef PG8_BAR
#undef PG8_SCHED
#undef PG8_GVOFF
}
#define PG8_GAS __attribute__((address_space(1)))
typedef const PG8_GAS char* gptr;
__device__ __forceinline__ gptr uniform_ptr(const char* p) { const unsigned long long v = (unsigned long long)p; const unsigned lo = __builtin_amdgcn_readfirstlane((unsigned)v), hi = __builtin_amdgcn_readfirstlane((unsigned)(v >> 32)); return (gptr)(((unsigned long long)hi << 32) | lo); }
struct WF32 { const float* W0; const float* W1; size_t estride; int pn_step; int ldw; };
typedef float f32x2 __attribute__((ext_vector_type(2)));
template <class Epi, class Sched, bool GATHER, int ROWMAP>
__device__ __forceinline__ void gemm_phase_wf32(PG8_LAS unsigned char* lds, const Gemm g, const Sched& S, const Epi& E, const WF32 wf) {
    static_assert(Epi::PERM, "the B staging map below is the PERM one");
    const int tid = threadIdx.x, wid = __builtin_amdgcn_readfirstlane(tid >> 6), lane = tid & 63, wr = wid >> 2, wc = wid & 3, fr = lane & 15, fq = lane >> 4;
    const int K = g.K, nt = K / BK;
    unsigned voffA[2][2]; int RA[2], CA[2];
#pragma unroll
    for (int i = 0; i < 2; ++i) { int R, C; stage_rc(tid * 16 + i * 8192, R, C); RA[i] = R; CA[i] = C; voffA[0][i] = (unsigned)(R * g.lda + C) * 2u; voffA[1][i] = (unsigned)((R + HALF) * g.lda + C) * 2u; }
    const size_t kstep = (size_t)(BK * 2);
    const unsigned ldsw = (unsigned)wid * 1024u, ldsb = (unsigned)(size_t)lds;
    const int aoff = lds_byte(wr * 64 + fr, fq * 8);
    const int bn_o = 2 * ((wid & 3) * 16 + (lane >> 2)), bc_o = bn_o & 31, bR_o = (bn_o & ~31) + 16 * ((bc_o >> 2) & 1) + 4 * (bc_o >> 3) + (bc_o & 3), bk_o = 32 * (wid >> 2) + 8 * (lane & 3);
    const int bn2 = 2 * lane, bc2 = bn2 & 31, bR2 = (bn2 & ~31) + 16 * ((bc2 >> 2) & 1) + 4 * (bc2 >> 3) + (bc2 & 3);
    const int bR = (ROWMAP == 1 || ROWMAP == 3 || ROWMAP == 5 || ROWMAP == 6) ? 2 * lane : ROWMAP == 2 ? bR2 : bR_o, bn = (ROWMAP == 1 || ROWMAP == 3 || ROWMAP == 5 || ROWMAP == 6) ? (bR & ~31) + perm32(bR & 31) : ROWMAP == 2 ? bn2 : bn_o;
    const unsigned vbo = (unsigned)((ROWMAP ? 8 * wid : bk_o) * wf.ldw + bn) * 4u;
    const int wb0 = (ROWMAP == 1 || ROWMAP == 5) ? bR * 128 + ((wid ^ (lane & 7)) << 4) : ROWMAP == 0 ? lds_byte(bR_o, bk_o) : lds_byte(bR, 8 * wid), wb1 = (ROWMAP == 1 || ROWMAP == 5) ? wb0 + 128 : ROWMAP == 0 ? lds_byte(bR_o + 1, bk_o) : lds_byte(bR + 1, 8 * wid);
    const int boff0 = (ROWMAP == 1 || ROWMAP == 6 || ROWMAP == 7) ? (wc * 32 + fr) * 128 + ((fq ^ (fr >> 1)) << 4) : lds_byte(wc * 32 + fr, fq * 8), boff1 = (ROWMAP == 1 || ROWMAP == 6 || ROWMAP == 7) ? (wc * 32 + fr) * 128 + (((fq + 4) ^ (fr >> 1)) << 4) : boff0 + 1024;
    const size_t ldwb = (size_t)wf.ldw * 4, kstepB = (size_t)BK * ldwb;
    const int c4 = 4 * (lane & 31), r4 = (c4 & ~31) + 16 * ((c4 >> 2) & 1) + 4 * ((c4 & 31) >> 3), s4 = (r4 >> 1) & 7;
    const unsigned vbo7 = (unsigned)((8 * wid + 4 * (lane >> 5)) * wf.ldw + c4) * 4u;
    const int wq0 = r4 * 128 + ((wid ^ s4) << 4) + 8 * (lane >> 5), wq2 = (r4 + 2) * 128 + ((wid ^ (s4 + 1)) << 4) + 8 * (lane >> 5);
#define PG8_SA(b, h) (((b) * 2 + (h)) * HTB)
#define PG8_SB(b, h) ((4 + (b) * 2 + (h)) * HTB)
#define PG8_STAGE(bufoff, gbase, voff) do { _Pragma("unroll") for (int _i = 0; _i < 2; ++_i) \
        { gptr _t; asm volatile("s_mov_b32 m0, %1\n\ts_mov_b64 %0, %3\n\tglobal_load_lds_dwordx4 %2, %0" : "=&s"(_t) : "s"(ldsb + (unsigned)(bufoff) + ldsw + _i * 8192u), "v"((voff)[_i]), "s"((gptr)(gbase)) : "memory"); } } while (0)
#define PG8_LDAH(dst, b, h, mh) do { _Pragma("unroll") for (int m = 0; m < 2; ++m) _Pragma("unroll") for (int k = 0; k < 2; ++k) dst[m][k] = *(const PG8_LAS bf16x8*)(lds + PG8_SA(b, h) + aoff + (2 * (mh) + m) * 2048 + k * 1024); } while (0)
#define PG8_LDB(dst, b, h) do { _Pragma("unroll") for (int n = 0; n < 2; ++n) { dst[n][0] = *(const PG8_LAS bf16x8*)(lds + PG8_SB(b, h) + boff0 + n * 2048); dst[n][1] = *(const PG8_LAS bf16x8*)(lds + PG8_SB(b, h) + boff1 + n * 2048); } } while (0)
#define PG8_MMAH(ai, mh) do { __builtin_amdgcn_s_setprio(1); _Pragma("unroll") for (int m = 0; m < 2; ++m) _Pragma("unroll") for (int n = 0; n < 2; ++n) _Pragma("unroll") for (int k = 0; k < 2; ++k) { \
        acc[ai][0][2 * (mh) + m][n] = __builtin_amdgcn_mfma_f32_16x16x32_bf16(B0[n][k], Ah[m][k], acc[ai][0][2 * (mh) + m][n], 0, 0, 0); \
        acc[ai][1][2 * (mh) + m][n] = __builtin_amdgcn_mfma_f32_16x16x32_bf16(B1[n][k], Ah[m][k], acc[ai][1][2 * (mh) + m][n], 0, 0, 0); } __builtin_amdgcn_s_setprio(0); } while (0)
#define PG8_BLOAD(X, src) do { if constexpr (ROWMAP == 7) { _Pragma("unroll") for (int _j = 0; _j < 4; ++_j) { const gptr _sj = (gptr)(src) + (size_t)_j * ldwb; gptr _t; asm volatile("s_mov_b64 %1, %3\n\tglobal_load_dwordx4 %0, %2, %1" : "=&v"(X##4[_j]), "=&s"(_t) : "v"(vbo7), "s"(_sj) : "memory"); } break; } _Pragma("unroll") for (int _j = 0; _j < 8; ++_j) { const gptr _sj = (gptr)(src) + (size_t)_j * ldwb; gptr _t; asm volatile("s_mov_b64 %1, %3\n\tglobal_load_dwordx2 %0, %2, %1" : "=&v"(X[_j]), "=&s"(_t) : "v"(vbo), "s"(_sj) : "memory"); } } while (0)
#define PG8_BWRITE(X, bufoff) do { if constexpr (ROWMAP == 7) { u32x2 _c0, _c1, _c2, _c3; \
        _c0.x = cvt_pk_bf16(X##4[0][0], X##4[1][0]); _c0.y = cvt_pk_bf16(X##4[2][0], X##4[3][0]); _c1.x = cvt_pk_bf16(X##4[0][1], X##4[1][1]); _c1.y = cvt_pk_bf16(X##4[2][1], X##4[3][1]); \
        _c2.x = cvt_pk_bf16(X##4[0][2], X##4[1][2]); _c2.y = cvt_pk_bf16(X##4[2][2], X##4[3][2]); _c3.x = cvt_pk_bf16(X##4[0][3], X##4[1][3]); _c3.y = cvt_pk_bf16(X##4[2][3], X##4[3][3]); \
        *(PG8_LAS u32x2*)(lds + (bufoff) + wq0) = _c0; *(PG8_LAS u32x2*)(lds + (bufoff) + wq0 + 128) = _c1; *(PG8_LAS u32x2*)(lds + (bufoff) + wq2) = _c2; *(PG8_LAS u32x2*)(lds + (bufoff) + wq2 + 128) = _c3; break; } u32x4 _w0, _w1; \
        _w0.x = cvt_pk_bf16(X[0].x, X[1].x); _w0.y = cvt_pk_bf16(X[2].x, X[3].x); _w0.z = cvt_pk_bf16(X[4].x, X[5].x); _w0.w = cvt_pk_bf16(X[6].x, X[7].x); \
        _w1.x = cvt_pk_bf16(X[0].y, X[1].y); _w1.y = cvt_pk_bf16(X[2].y, X[3].y); _w1.z = cvt_pk_bf16(X[4].y, X[5].y); _w1.w = cvt_pk_bf16(X[6].y, X[7].y); \
        *(PG8_LAS u32x4*)(lds + (bufoff) + wb0) = _w0; *(PG8_LAS u32x4*)(lds + (bufoff) + wb1) = _w1; } while (0)
#define PG8_WAIT_V(n) do { if constexpr (ROWMAP == 7 && (n) == 12) asm volatile("s_waitcnt vmcnt(8)" ::: "memory"); else if constexpr (ROWMAP == 7 && (n) == 10) asm volatile("s_waitcnt vmcnt(6)" ::: "memory"); \
        else if constexpr (ROWMAP == 7 && (n) == 8) asm volatile("s_waitcnt vmcnt(4)" ::: "memory"); else asm volatile("s_waitcnt vmcnt(" #n ")" ::: "memory"); } while (0)
#define PG8_WAIT_L(n) asm volatile("s_waitcnt lgkmcnt(" #n ")" ::: "memory")
#define PG8_BAR __builtin_amdgcn_s_barrier()
#define PG8_SCHED __builtin_amdgcn_sched_barrier(0)
#define PG8_GVOFF(u, vo) do { if constexpr (GATHER) { _Pragma("unroll") for (int _h = 0; _h < 2; ++_h) _Pragma("unroll") for (int _i = 0; _i < 2; ++_i) \
        vo[_h][_i] = (unsigned)(S.a_row(u, _h * HALF + RA[_i]) * g.lda + CA[_i]) * 2u; } } while (0)
    Unit cur, nxt; int ui = 0;
    if (!S.next(0, cur)) return;
    f32x4 acc[2][2][4][2];
#pragma unroll
    for (int a = 0; a < 2; ++a)
#pragma unroll
        for (int b = 0; b < 2; ++b)
#pragma unroll
            for (int m = 0; m < 4; ++m)
#pragma unroll
                for (int n = 0; n < 2; ++n) acc[a][b][m][n] = (f32x4){0.f, 0.f, 0.f, 0.f};
    bf16x8 Ah[2][2], B0[2][2], B1[2][2];
    f32x2 X[8], Y[8]; f32x4 X4[4], Y4[4];
    unsigned nvoffA[2][2];
    PG8_GVOFF(cur, voffA);
    gptr cA = uniform_ptr(S.a_base(cur)); gptr cB0 = uniform_ptr(S.w_base(cur, wf, 0)); gptr cB1 = uniform_ptr(S.w_base(cur, wf, 1));
    PG8_BLOAD(X, cB0); PG8_BLOAD(Y, cB1);
    PG8_STAGE(PG8_SA(0, 0), cA, voffA[0]); PG8_STAGE(PG8_SA(0, 1), cA, voffA[1]);
    PG8_WAIT_V(12); PG8_BWRITE(X, PG8_SB(0, 0)); PG8_BLOAD(X, cB0 + kstepB);
    PG8_WAIT_V(12); PG8_BWRITE(Y, PG8_SB(0, 1)); PG8_BLOAD(Y, cB1 + kstepB);
    PG8_WAIT_V(8); PG8_BWRITE(X, PG8_SB(1, 0)); PG8_BLOAD(X, cB0 + 2 * kstepB);
    PG8_STAGE(PG8_SA(1, 0), cA + kstep, voffA[0]);
    PG8_WAIT_V(10); PG8_BWRITE(Y, PG8_SB(1, 1)); PG8_BLOAD(Y, cB1 + 2 * kstepB);
    PG8_WAIT_L(0);
    if (wr == 1) PG8_BAR;
    PG8_BAR;
    for (;;) {
        const bool has_next = S.next(ui + 1, nxt);
        const bool hf = S.half(cur);
        const gptr nA = has_next ? uniform_ptr(S.a_base(nxt)) : cA;
        const gptr nB0 = has_next ? uniform_ptr(S.w_base(nxt, wf, 0)) : cB0; const gptr nB1 = has_next ? uniform_ptr(S.w_base(nxt, wf, 1)) : cB1;
        if constexpr (GATHER) { if (has_next) { PG8_GVOFF(nxt, nvoffA); } else {
#pragma unroll
            for (int _h = 0; _h < 2; ++_h)
#pragma unroll
                for (int _i = 0; _i < 2; ++_i) nvoffA[_h][_i] = voffA[_h][_i]; } }
        for (int t = 0; t < nt; t += 2) {
            const bool last = (t == nt - 2);
            const gptr a1 = cA + (size_t)(t + 1) * kstep;
            const gptr a2 = last ? nA : cA + (size_t)(t + 2) * kstep; const gptr a3 = a2 + kstep;
            unsigned va0[2], va1[2];
            if constexpr (GATHER) { va0[0] = last ? nvoffA[0][0] : voffA[0][0]; va0[1] = last ? nvoffA[0][1] : voffA[0][1]; va1[0] = last ? nvoffA[1][0] : voffA[1][0]; va1[1] = last ? nvoffA[1][1] : voffA[1][1]; }
            else { va0[0] = voffA[0][0]; va0[1] = voffA[0][1]; va1[0] = voffA[1][0]; va1[1] = voffA[1][1]; }
            const size_t o3 = (t + 3 < nt) ? (size_t)(t + 3) * kstepB : (size_t)(t + 3 - nt) * kstepB, o4 = (t + 4 < nt) ? (size_t)(t + 4) * kstepB : (size_t)(t + 4 - nt) * kstepB;
            const gptr x3 = ((t + 3 < nt) ? cB0 : nB0) + o3; const gptr y3 = ((t + 3 < nt) ? cB1 : nB1) + o3;
            const gptr x4 = ((t + 4 < nt) ? cB0 : nB0) + o4; const gptr y4 = ((t + 4 < nt) ? cB1 : nB1) + o4;
            PG8_LDB(B0, 0, 0); PG8_LDB(B1, 0, 1); PG8_SCHED; PG8_LDAH(Ah, 0, 0, 0); PG8_STAGE(PG8_SA(1, 1), a1, voffA[1]);
            PG8_WAIT_L(0); PG8_BAR; PG8_MMAH(0, 0); PG8_BAR; PG8_SCHED;
            PG8_LDAH(Ah, 0, 0, 1); PG8_WAIT_V(12); PG8_BWRITE(X, PG8_SB(0, 0)); PG8_BLOAD(X, x3);
            PG8_WAIT_L(0); PG8_BAR; PG8_MMAH(0, 1); PG8_BAR; PG8_SCHED;
            PG8_LDAH(Ah, 0, 1, 0); PG8_STAGE(PG8_SA(0, 0), a2, va0);
            PG8_WAIT_L(0); PG8_BAR; if (!hf) { PG8_MMAH(1, 0); } PG8_BAR; PG8_SCHED;
            PG8_LDAH(Ah, 0, 1, 1); PG8_WAIT_V(10); PG8_BWRITE(Y, PG8_SB(0, 1)); PG8_BLOAD(Y, y3);
            PG8_WAIT_L(0); PG8_BAR; if (!hf) { PG8_MMAH(1, 1); } PG8_BAR; PG8_SCHED;
            PG8_LDB(B0, 1, 0); PG8_LDB(B1, 1, 1); PG8_SCHED; PG8_LDAH(Ah, 1, 0, 0); PG8_STAGE(PG8_SA(0, 1), a2, va1);
            PG8_WAIT_L(0); PG8_BAR; PG8_MMAH(0, 0); PG8_BAR; PG8_SCHED;
            PG8_LDAH(Ah, 1, 0, 1); PG8_WAIT_V(12); PG8_BWRITE(X, PG8_SB(1, 0)); PG8_BLOAD(X, x4);
            PG8_WAIT_L(0); PG8_BAR; PG8_MMAH(0, 1); PG8_BAR; PG8_SCHED;
            PG8_LDAH(Ah, 1, 1, 0); PG8_STAGE(PG8_SA(1, 0), a3, va0);
            PG8_WAIT_L(0); PG8_BAR; if (!hf) { PG8_MMAH(1, 0); } PG8_BAR; PG8_SCHED;
            PG8_LDAH(Ah, 1, 1, 1); PG8_WAIT_V(10); PG8_BWRITE(Y, PG8_SB(1, 1)); PG8_BLOAD(Y, y4);
            PG8_WAIT_L(0); PG8_BAR; if (!hf) { PG8_MMAH(1, 1); } PG8_BAR; PG8_SCHED;
        }
        if (wr == 0) PG8_BAR;
        E(acc, cur, wr, wc, fr, fq);
        if (!has_next) break;
#pragma unroll
        for (int a = 0; a < 2; ++a)
#pragma unroll
            for (int b = 0; b < 2; ++b)
#pragma unroll
                for (int m = 0; m < 4; ++m)
#pragma unroll
                    for (int n = 0; n < 2; ++n) acc[a][b][m][n] = (f32x4){0.f, 0.f, 0.f, 0.f};
        cur = nxt; cA = nA; cB0 = nB0; cB1 = nB1; ++ui;
        if constexpr (GATHER) {
#pragma unroll
            for (int _h = 0; _h < 2; ++_h)
#pragma unroll
                for (int _i = 0; _i < 2; ++_i) voffA[_h][_i] = nvoffA[_h][_i]; }
        if (wr == 1) PG8_BAR;
    }
    PG8_WAIT_V(0);
    PG8_BAR;
#undef PG8_SA
#undef PG8_SB
#undef PG8_STAGE
#undef PG8_LDAH
#undef PG8_LDB
#undef PG8_MMAH
#undef PG8_BLOAD
#undef PG8_BWRITE
#undef PG8_WAIT_V
#undef PG8_WAIT_L
#undef PG8_BAR
#undef PG8_SCHED
#undef PG8_GVOFF
}
struct EpiBf16Plain {
    static constexpr bool PERM = true;
    bf16_t* O; size_t ldc;
    __device__ __forceinline__ void operator()(const f32x4 (&acc)[2][2][4][2], const Unit& u, int wr, int wc, int fr, int fq) const {
        const int row0 = u.pm * BM + wr * 64 + fr, col0 = u.pn * BM + wc * 32 + 8 * fq;
#pragma unroll
        for (int ai = 0; ai < 2; ++ai)
#pragma unroll
            for (int m = 0; m < 4; ++m) { bf16_t* rowp = O + (size_t)(row0 + ai * HALF + m * 16) * ldc + col0;
#pragma unroll
                for (int bj = 0; bj < 2; ++bj) { const f32x4 v0 = acc[ai][bj][m][0], v1 = acc[ai][bj][m][1];
                    u32x4 w; w.x = cvt_pk_bf16(v0[0], v0[1]); w.y = cvt_pk_bf16(v0[2], v0[3]); w.z = cvt_pk_bf16(v1[0], v1[1]); w.w = cvt_pk_bf16(v1[2], v1[3]);
                    __builtin_nontemporal_store(w, (u32x4*)(rowp + bj * HALF)); } }
    }
};

struct EpiBrA {
    static constexpr bool PERM = true;
    bf16_t* T1S; const bf16_t* ZP;
    __device__ __forceinline__ void operator()(const f32x4 (&acc)[2][2][4][2], const Unit& u, int wr, int wc, int fr, int fq) const {
        const int row0 = u.pm * BM + wr * 64 + fr, col0 = u.pn * BM + wc * 32 + 8 * fq;
        u32x4 gq[2][4][2];
#pragma unroll
        for (int ai = 0; ai < 2; ++ai)
#pragma unroll
            for (int m = 0; m < 4; ++m) { const size_t pr = (size_t)prow_of(row0 + ai * HALF + m * 16) * NIN + C_GA;
#pragma unroll
                for (int bj = 0; bj < 2; ++bj) gq[ai][m][bj] = *(const u32x4*)(ZP + pr + col0 + bj * HALF); }
        __builtin_amdgcn_sched_barrier(0);
#pragma unroll
        for (int ai = 0; ai < 2; ++ai)
#pragma unroll
            for (int m = 0; m < 4; ++m) { const int row = row0 + ai * HALF + m * 16;
#pragma unroll
                for (int bj = 0; bj < 2; ++bj) { const int col = col0 + bj * HALF; const u32x4 gw = gq[ai][m][bj];
                    const f32x4 v0 = acc[ai][bj][m][0], v1 = acc[ai][bj][m][1]; u32x4 w;
                    w.x = cvt_pk_bf16(sigmoidf(bf_lo(gw.x)) * v0[0], sigmoidf(bf_hi(gw.x)) * v0[1]); w.y = cvt_pk_bf16(sigmoidf(bf_lo(gw.y)) * v0[2], sigmoidf(bf_hi(gw.y)) * v0[3]);
                    w.z = cvt_pk_bf16(sigmoidf(bf_lo(gw.z)) * v1[0], sigmoidf(bf_hi(gw.z)) * v1[1]); w.w = cvt_pk_bf16(sigmoidf(bf_lo(gw.w)) * v1[2], sigmoidf(bf_hi(gw.w)) * v1[3]);
                    *(u32x4*)(T1S + (size_t)row * DM + col) = w; } }
    }
};
struct EpiBrS {
    static constexpr bool PERM = true;
    const bf16_t* T1S; const bf16_t* ZP; bf16_t* MG;
    __device__ __forceinline__ void operator()(const f32x4 (&acc)[2][2][4][2], const Unit& u, int wr, int wc, int fr, int fq) const {
        const int row0 = u.pm * BM + wr * 64 + fr, col0 = u.pn * BM + wc * 32 + 8 * fq;
#pragma unroll
        for (int ai = 0; ai < 2; ++ai) {
            u32x4 gq[4][2], tq[4][2];
#pragma unroll
            for (int m = 0; m < 4; ++m) { const int row = row0 + ai * HALF + m * 16; const size_t pr = (size_t)prow_of(row) * NIN + C_GS;
#pragma unroll
                for (int bj = 0; bj < 2; ++bj) { gq[m][bj] = *(const u32x4*)(ZP + pr + col0 + bj * HALF); tq[m][bj] = *(const u32x4*)(T1S + (size_t)row * DM + col0 + bj * HALF); } }
            __builtin_amdgcn_sched_barrier(0);
#pragma unroll
            for (int m = 0; m < 4; ++m) { const int row = row0 + ai * HALF + m * 16;
#pragma unroll
                for (int bj = 0; bj < 2; ++bj) { const int col = col0 + bj * HALF; const u32x4 gw = gq[m][bj], tw = tq[m][bj];
                    const f32x4 v0 = acc[ai][bj][m][0], v1 = acc[ai][bj][m][1]; u32x4 w;
                    w.x = cvt_pk_bf16(bf_lo(tw.x) + sigmoidf(bf_lo(gw.x)) * v0[0], bf_hi(tw.x) + sigmoidf(bf_hi(gw.x)) * v0[1]);
                    w.y = cvt_pk_bf16(bf_lo(tw.y) + sigmoidf(bf_lo(gw.y)) * v0[2], bf_hi(tw.y) + sigmoidf(bf_hi(gw.y)) * v0[3]);
                    w.z = cvt_pk_bf16(bf_lo(tw.z) + sigmoidf(bf_lo(gw.z)) * v1[0], bf_hi(tw.z) + sigmoidf(bf_hi(gw.z)) * v1[1]);
                    w.w = cvt_pk_bf16(bf_lo(tw.w) + sigmoidf(bf_lo(gw.w)) * v1[2], bf_hi(tw.w) + sigmoidf(bf_hi(gw.w)) * v1[3]);
                    *(u32x4*)(MG + (size_t)row * DM + col) = w; } }
            __builtin_amdgcn_sched_barrier(0);
        }
    }
};
struct EpiWo {
    static constexpr bool PERM = false;
    float* U; const float* x; const float* rowstat; const float* g; const float* bt;
    __device__ __forceinline__ void operator()(const f32x4 (&acc)[2][2][4][2], const Unit& u, int wr, int wc, int fr, int fq) const {
        const int row0 = u.pm * BM + wr * 64 + fr, col0 = u.pn * BM + wc * 32 + 4 * fq;
        f32x4 gv[2][2], bv[2][2];
#pragma unroll
        for (int bj = 0; bj < 2; ++bj)
#pragma unroll
            for (int n = 0; n < 2; ++n) { const int c = col0 + bj * HALF + n * 16; gv[bj][n] = *(const f32x4*)(g + c); bv[bj][n] = *(const f32x4*)(bt + c); }
#pragma unroll
        for (int ai = 0; ai < 2; ++ai)
#pragma unroll
            for (int mh = 0; mh < 2; ++mh) {
                f32x4 xq[2][2][2]; float mean[2], rstd[2];
#pragma unroll
                for (int mm = 0; mm < 2; ++mm) { const int row = row0 + ai * HALF + (2 * mh + mm) * 16; mean[mm] = rowstat[2 * row]; rstd[mm] = rowstat[2 * row + 1];
#pragma unroll
                    for (int bj = 0; bj < 2; ++bj)
#pragma unroll
                        for (int n = 0; n < 2; ++n) xq[mm][bj][n] = *(const f32x4*)(x + (size_t)row * DM + col0 + bj * HALF + n * 16); }
                __builtin_amdgcn_sched_barrier(0);
#pragma unroll
                for (int mm = 0; mm < 2; ++mm) { const int m = 2 * mh + mm, row = row0 + ai * HALF + m * 16;
#pragma unroll
                    for (int bj = 0; bj < 2; ++bj)
#pragma unroll
                        for (int n = 0; n < 2; ++n) { const int c = col0 + bj * HALF + n * 16;
                            *(f32x4*)(U + (size_t)row * DM + c) = ((xq[mm][bj][n] - mean[mm]) * rstd[mm] * gv[bj][n] + bv[bj][n]) * ALPHA + acc[ai][bj][m][n]; } }
                __builtin_amdgcn_sched_barrier(0);
            }
    }
};
struct EpiGateUp {
    static constexpr bool PERM = true;
    bf16_t* HID;
    __device__ __forceinline__ void operator()(const f32x4 (&acc)[2][2][4][2], const Unit& u, int wr, int wc, int fr, int fq) const {
        const int pos0 = u.pm * BM + wr * 64 + fr, col0 = u.pn * HALF + wc * 32 + 8 * fq;
#pragma unroll
        for (int ai = 0; ai < 2; ++ai)
#pragma unroll
            for (int m = 0; m < 4; ++m) { const int pos = pos0 + ai * HALF + m * 16;
                const f32x4 g0 = acc[ai][0][m][0], g1 = acc[ai][0][m][1], u0 = acc[ai][1][m][0], u1 = acc[ai][1][m][1]; u32x4 w;
                w.x = cvt_pk_bf16(siluf(g0[0]) * u0[0], siluf(g0[1]) * u0[1]); w.y = cvt_pk_bf16(siluf(g0[2]) * u0[2], siluf(g0[3]) * u0[3]);
                w.z = cvt_pk_bf16(siluf(g1[0]) * u1[0], siluf(g1[1]) * u1[1]); w.w = cvt_pk_bf16(siluf(g1[2]) * u1[2], siluf(g1[3]) * u1[3]);
                *(u32x4*)(HID + (size_t)pos * DE + col0) = w; }
    }
};
struct MoeTiles { const PG8_LAS int* te; const PG8_LAS int* tf; const PG8_LAS int* tn; const int* list_ent; const float* list_w; };
struct EpiDown {
    static constexpr bool PERM = true;
    bf16_t* Y; MoeTiles T;
    __device__ __forceinline__ void operator()(const f32x4 (&acc)[2][2][4][2], const Unit& u, int wr, int wc, int fr, int fq) const {
        const int r0 = wr * 64 + fr, col0 = u.pn * BM + wc * 32 + 8 * fq;
        const int e = T.te[u.pm], first = T.tf[u.pm], nv = T.tn[u.pm];
        int ent[2][4]; float wt[2][4];
#pragma unroll
        for (int ai = 0; ai < 2; ++ai)
#pragma unroll
            for (int m = 0; m < 4; ++m) { const int r = r0 + ai * HALF + m * 16, rc = r < nv ? r : nv - 1;
                ent[ai][m] = T.list_ent[e * MR + first + rc]; wt[ai][m] = T.list_w[e * MR + first + rc]; }
#pragma unroll
        for (int ai = 0; ai < 2; ++ai)
#pragma unroll
            for (int m = 0; m < 4; ++m) { const int r = r0 + ai * HALF + m * 16;
                if (r < nv) {
#pragma unroll
                    for (int bj = 0; bj < 2; ++bj) { const f32x4 v0 = acc[ai][bj][m][0] * wt[ai][m], v1 = acc[ai][bj][m][1] * wt[ai][m]; u32x4 w;
                        w.x = cvt_pk_bf16(v0[0], v0[1]); w.y = cvt_pk_bf16(v0[2], v0[3]); w.z = cvt_pk_bf16(v1[0], v1[1]); w.w = cvt_pk_bf16(v1[2], v1[3]);
                        *(u32x4*)(Y + (size_t)ent[ai][m] * DM + col0 + bj * HALF) = w; } } }
    }
};
struct MoeOrder {
    int nN, nwg, G, c; const bf16_t* A; int lda; const bf16_t* Bt; size_t b_stride; int ldb; MoeTiles T; bool gather;
    __device__ bool next(int i, Unit& u) const { const long L = (long)i * G + c; if (L >= nwg) return false; u.pm = (int)(L / nN); u.pn = (int)(L % nN); return true; }
    __device__ __forceinline__ const char* a_base(const Unit& u) const { return gather ? (const char*)A : (const char*)(A + (size_t)u.pm * BM * lda); }
    __device__ __forceinline__ const char* b_base(const Unit& u) const { return (const char*)(Bt + (size_t)T.te[u.pm] * b_stride + (size_t)u.pn * BM * ldb); }
    __device__ __forceinline__ const char* w_base(const Unit& u, const WF32& wf, int h) const { return (const char*)((h ? wf.W1 : wf.W0) + (size_t)T.te[u.pm] * wf.estride + (size_t)u.pn * wf.pn_step); }
    __device__ __forceinline__ bool half(const Unit& u) const { return T.tn[u.pm] <= HALF; }
    __device__ __forceinline__ int a_row(const Unit& u, int r) const { const int idx = T.list_ent[T.te[u.pm] * MR + T.tf[u.pm] + (r < T.tn[u.pm] ? r : 0)]; return r < T.tn[u.pm] ? (idx >> 1) : 0; }
};
}

#define XB_TMO      128
#define XB_XCNT(j)  (256  + 64 * (j))
#define XB_XSUB(j)  (1280 + 64 * (j))
#define XB_XGEN(j)  (2304 + 64 * (j))
#define XB_TOP      3328
#define XB_TOPGEN   3392
#define XCD_BAR_WORDS 3456
#define XB_SPIN_CAP (1u << 18)
__device__ __forceinline__ unsigned xb_ld(unsigned* p)              { return __hip_atomic_load(p, __ATOMIC_RELAXED, __HIP_MEMORY_SCOPE_AGENT); }
__device__ __forceinline__ unsigned xb_add(unsigned* p, unsigned v) { return __hip_atomic_fetch_add(p, v, __ATOMIC_RELAXED, __HIP_MEMORY_SCOPE_AGENT); }
__device__ __forceinline__ unsigned xb_xcc_id() { return (unsigned)__builtin_amdgcn_s_getreg((3 << 11) | 20) & 0xFu; }
#define XB_SPIN(cond, bar) do { unsigned _sp = 0; while (cond) { __builtin_amdgcn_s_sleep(1); \
    if ((++_sp & 255u) == 0u) { if (xb_ld(&(bar)[XB_TMO])) break; if (_sp > XB_SPIN_CAP) { atomicAdd(&(bar)[XB_TMO], 1u); break; } } } } while (0)
struct XcdBarrier { unsigned* bar; unsigned x; volatile LAS unsigned* st; };
__device__ __forceinline__ XcdBarrier xcd_barrier_post(unsigned* bar, volatile LAS unsigned* st) {
    XcdBarrier b; b.bar = bar; b.x = xb_xcc_id(); b.st = st;
    if (threadIdx.x == 0) (void)xb_add(&bar[XB_XCNT(b.x)], 1u);
    return b;
}
__device__ __forceinline__ void xcd_barrier_complete(unsigned* bar, unsigned x, unsigned& nloc, unsigned& nx) {
    const unsigned G = gridDim.x * gridDim.y * gridDim.z;
    unsigned sum, cnt, mine, sp = 0u;
    for (;;) {
        sum = 0u; cnt = 0u; mine = 0u;
#pragma unroll
        for (unsigned j = 0; j < 16; ++j) { const unsigned c = xb_ld(&bar[XB_XCNT(j)]); sum += c; cnt += (c > 0u) ? 1u : 0u; mine = (j == x) ? c : mine; }
        if (sum == G) break;
        __builtin_amdgcn_s_sleep(1);
        if ((++sp & 255u) == 0u) { if (xb_ld(&bar[XB_TMO])) break; if (sp > XB_SPIN_CAP) { atomicAdd(&bar[XB_TMO], 1u); break; } }
    }
    nloc = mine > 0u ? mine : 1u; nx = cnt > 0u ? cnt : 1u;
}
__device__ __forceinline__ void xcd_barrier(const XcdBarrier& b) {
    asm volatile("s_waitcnt vmcnt(0)" ::: "memory");
    __syncthreads();
    if (threadIdx.x == 0) {
        unsigned* bar = b.bar;
        __builtin_amdgcn_s_waitcnt(0);
        unsigned nloc = b.st[0], nx = b.st[1];
        if (nloc == 0u) { xcd_barrier_complete(bar, b.x, nloc, nx); b.st[0] = nloc; b.st[1] = nx; }
        const unsigned old = xb_add(&bar[XB_XSUB(b.x)], 1u);
        const unsigned gen = old / nloc;
        if (old + 1u == (gen + 1u) * nloc) {
            __builtin_amdgcn_fence(__ATOMIC_RELEASE, "agent");
            asm volatile("s_waitcnt vmcnt(0)" ::: "memory");
            const unsigned og = xb_add(&bar[XB_TOP], 1u);
            const unsigned tg = og / nx;
            if (og + 1u == (tg + 1u) * nx) xb_add(&bar[XB_TOPGEN], 1u);
            else XB_SPIN(xb_ld(&bar[XB_TOPGEN]) == tg, bar);
            __builtin_amdgcn_fence(__ATOMIC_ACQUIRE, "agent");
            xb_add(&bar[XB_XGEN(b.x)], 1u);
            asm volatile("s_waitcnt vmcnt(0)" ::: "memory");
        } else {
            XB_SPIN(xb_ld(&bar[XB_XGEN(b.x)]) == gen, bar);
            __builtin_amdgcn_fence(__ATOMIC_ACQUIRE, "agent");
            asm volatile("s_waitcnt vmcnt(0)" ::: "memory");
        }
    }
    __syncthreads();
}

DEVINL void tr_item(const float* __restrict__ W, int ld, int c0, int k0, bf16_t* __restrict__ WT, size_t drow0, int K, LAS float* scr, int lane, bool zero) {
#pragma unroll
    for (int i = 0; i < 8; ++i) { const int kk = 8 * i + (lane >> 3), cc = 4 * (lane & 7);
        const pg8::f32x4 w4 = zero ? (pg8::f32x4){0.f, 0.f, 0.f, 0.f} : __builtin_nontemporal_load((const pg8::f32x4*)(W + (size_t)(k0 + kk) * ld + c0 + cc));
        scr[kk * 33 + cc] = w4[0]; scr[kk * 33 + cc + 1] = w4[1]; scr[kk * 33 + cc + 2] = w4[2]; scr[kk * 33 + cc + 3] = w4[3]; }
    LDS_WAIT();
    const int c = lane & 7;
#pragma unroll
    for (int j = 0; j < 4; ++j) { const int n = (lane >> 3) + 8 * j; const LAS float* s = scr + (8 * c) * 33 + n;
        uint4 o; o.x = pk2(s[0 * 33], s[1 * 33]); o.y = pk2(s[2 * 33], s[3 * 33]); o.z = pk2(s[4 * 33], s[5 * 33]); o.w = pk2(s[6 * 33], s[7 * 33]);
        *(uint4*)(WT + (drow0 + n) * (size_t)K + k0 + 8 * c) = o; }
    LDS_WAIT();
}
struct P { const float* in[26]; float* out; unsigned char* ws; int ph_lo, ph_hi; };

DEVINL void phase_weights(const P& p, LAS float* scr, int gw, int NGW, int lane, bool moe, int it0 = 0, int it1 = 1 << 30) {
    unsigned char* ws = p.ws;
    constexpr int I_IN = 32 * 344, I_BRA = 16 * 64, I_BRS = 32 * 64, I_O = 32 * 64, I_GU = 64 * 32 * 32, I_DN = 64 * 8 * 64;
    constexpr int NDENSE = I_IN + I_BRA + I_BRS + I_O, NMOE = I_GU + I_DN;
    const int itend = (moe ? NMOE : NDENSE) < it1 ? (moe ? NMOE : NDENSE) : it1;
    for (int it = it0 + gw; it < itend; it += NGW) {
        int r = moe ? it + NDENSE : it;
        if (r < I_IN) { const int kb = r / 344, nb = r % 344, n = nb * 32; int c0 = n; bool zero = false;
            if (n < 6656) c0 = n; else if (n < 10752) c0 = n + 32; else if (n < 10784) c0 = n - 4096; else { zero = true; c0 = 0; }
            tr_item(p.in[4], 10784, c0, kb * 64, (bf16_t*)(ws + WS_WIN), (size_t)n, DM, scr, lane, zero); continue; } r -= I_IN;
        if (r < I_BRA) { const int kb = r / 64, nb = r % 64; tr_item(p.in[12], DM, nb * 32, kb * 64, (bf16_t*)(ws + WS_WBRA), (size_t)nb * 32, 1024, scr, lane, false); continue; } r -= I_BRA;
        if (r < I_BRS) { const int kb = r / 64, nb = r % 64; tr_item(p.in[13], DM, nb * 32, kb * 64, (bf16_t*)(ws + WS_WBRS), (size_t)nb * 32, DM, scr, lane, false); continue; } r -= I_BRS;
        if (r < I_O) { const int kb = r / 64, nb = r % 64; tr_item(p.in[14], DM, nb * 32, kb * 64, (bf16_t*)(ws + WS_WO), (size_t)nb * 32, DM, scr, lane, false); continue; } r -= I_O;
        if (r < I_GU) { const int e = r >> 10, q = r & 1023, kb = q >> 5, nb = q & 31, pn = nb >> 3, w = nb & 7;
            const float* src = (w < 4 ? p.in[21] : p.in[22]) + (size_t)e * DM * DE;
            tr_item(src, DE, pn * 128 + (w & 3) * 32, kb * 64, (bf16_t*)(ws + WS_WGU), (size_t)e * 1024 + nb * 32, DM, scr, lane, false); continue; } r -= I_GU;
        { const int e = r >> 9, q = r & 511, kb = q >> 6, nb = q & 63;
            tr_item(p.in[23] + (size_t)e * DE * DM, DM, nb * 32, kb * 64, (bf16_t*)(ws + WS_WDN), (size_t)e * DM + nb * 32, DE, scr, lane, false); }
    }
}
DEVINL void ln0_row(const P& p, int R, int lane) {
    const int b = R / LP, pp = R % LP;
    uint2* orow = (uint2*)((bf16_t*)(p.ws + WS_H0) + (size_t)R * DM);
    if (pp < 112) {
#pragma unroll
        for (int j = 0; j < 8; ++j) orow[lane + 64 * j] = make_uint2(0u, 0u);
        return;
    }
    const float* src = pp < 128 ? p.in[1] + (size_t)(pp - 112) * DM : p.in[0] + ((size_t)b * SEQ + (pp - 128)) * DM;
    const float* g = p.in[2]; const float* bt = p.in[3];
    float4 v[8]; float s = 0.f;
#pragma unroll
    for (int j = 0; j < 8; ++j) { v[j] = ((const float4*)src)[lane + 64 * j]; s += (v[j].x + v[j].y) + (v[j].z + v[j].w); }
    const float mean = wave_sum(s) * (1.f / DM); float q = 0.f;
#pragma unroll
    for (int j = 0; j < 8; ++j) { v[j].x -= mean; v[j].y -= mean; v[j].z -= mean; v[j].w -= mean; q += (v[j].x * v[j].x + v[j].y * v[j].y) + (v[j].z * v[j].z + v[j].w * v[j].w); }
    const float rstd = 1.f / sqrtf(wave_sum(q) * (1.f / DM) + LN_EPS);
#pragma unroll
    for (int j = 0; j < 8; ++j) {
        const float4 gg = ((const float4*)g)[lane + 64 * j], bb = ((const float4*)bt)[lane + 64 * j];
        orow[lane + 64 * j] = make_uint2(pk2(v[j].x * rstd * gg.x + bb.x, v[j].y * rstd * gg.y + bb.y), pk2(v[j].z * rstd * gg.z + bb.z, v[j].w * rstd * gg.w + bb.w));
    }
    if (pp >= 128 && lane == 0) { float* rowstat = (float*)(p.ws + OFF_ROWSTAT); const int r = b * SEQ + pp - 128; rowstat[2 * r] = mean; rowstat[2 * r + 1] = rstd; }
}
template <bool DISPATCH> DEVINL void ln1_router_row(const P& p, int r, int rnext, float4 (&vin)[8], int lane, LAS float* scr, const LAS float* wrgl, LAS int* res) {
    const float* U = (const float*)(p.ws + WS_U); bf16_t* H1B = (bf16_t*)(p.ws + WS_H1B);
    const float* g1 = p.in[15]; const float* b1 = p.in[16]; const float* brg = p.in[18]; const float* bre = p.in[20];
    const float* wreg = (const float*)(p.ws + OFF_WREG);
    float4 v[8]; float s = 0.f;
#pragma unroll
    for (int j = 0; j < 8; ++j) { v[j] = vin[j]; s += (v[j].x + v[j].y) + (v[j].z + v[j].w); }
    if (rnext >= 0) {
        const float4* upn = (const float4*)(U + (size_t)rnext * DM);
#pragma unroll
        for (int j = 0; j < 8; ++j) vin[j] = upn[lane + 64 * j]; }
    const float mean = wave_sum(s) * (1.f / DM); float q = 0.f;
#pragma unroll
    for (int j = 0; j < 8; ++j) { v[j].x -= mean; v[j].y -= mean; v[j].z -= mean; v[j].w -= mean; q += (v[j].x * v[j].x + v[j].y * v[j].y) + (v[j].z * v[j].z + v[j].w * v[j].w); }
    const float rstd = 1.f / sqrtf(wave_sum(q) * (1.f / DM) + LN_EPS);
    if (DISPATCH && lane == 0) { float* rs1 = (float*)(p.ws + OFF_ROWSTAT1); rs1[2 * r] = mean; rs1[2 * r + 1] = rstd; }
    uint2* hb = (uint2*)(H1B + (size_t)r * DM);
#pragma unroll
    for (int j = 0; j < 8; ++j) {
        const float4 gg = ((const float4*)g1)[lane + 64 * j], bb = ((const float4*)b1)[lane + 64 * j];
        v[j].x = v[j].x * rstd * gg.x + bb.x; v[j].y = v[j].y * rstd * gg.y + bb.y; v[j].z = v[j].z * rstd * gg.z + bb.z; v[j].w = v[j].w * rstd * gg.w + bb.w;
        if (DISPATCH) hb[lane + 64 * j] = make_uint2(pk2(v[j].x, v[j].y), pk2(v[j].z, v[j].w));
        *(LAS pg8::f32x4*)(scr + 4 * (lane + 64 * j)) = (pg8::f32x4){v[j].x, v[j].y, v[j].z, v[j].w};
    }
    LDS_WAIT();
    float lg[8];
#pragma unroll
    for (int c = 0; c < 8; ++c) lg[c] = 0.f;
#pragma unroll 8
    for (int t = 0; t < 32; ++t) {
        const int i = lane + 64 * t; const float h = scr[i];
        const pg8::f32x4 w0 = *(const LAS pg8::f32x4*)(wrgl + i * 8), w1 = *(const LAS pg8::f32x4*)(wrgl + i * 8 + 4);
        lg[0] += h * w0[0]; lg[1] += h * w0[1]; lg[2] += h * w0[2]; lg[3] += h * w0[3];
        lg[4] += h * w1[0]; lg[5] += h * w1[1]; lg[6] += h * w1[2]; lg[7] += h * w1[3];
    }
#pragma unroll
    for (int c = 0; c < 8; ++c) lg[c] = wave_sum(lg[c]) + brg[c];
    int gi = 0; float gm = lg[0];
#pragma unroll
    for (int c = 1; c < 8; ++c) if (lg[c] > gm) { gm = lg[c]; gi = c; }
    float den = 0.f;
#pragma unroll
    for (int c = 0; c < 8; ++c) den += __expf(lg[c] - gm);
    const float ptop = 1.f / den;
    float sel[8];
#pragma unroll
    for (int c = 0; c < 8; ++c) sel[c] = 0.f;
    const float* wgp = wreg + ((size_t)gi * DM + lane) * 8;
#pragma unroll 8
    for (int t = 0; t < 32; ++t) {
        const float h = scr[lane + 64 * t];
        const float4 w0 = *(const float4*)(wgp + (size_t)t * 512), w1 = *(const float4*)(wgp + (size_t)t * 512 + 4);
        sel[0] += h * w0.x; sel[1] += h * w0.y; sel[2] += h * w0.z; sel[3] += h * w0.w;
        sel[4] += h * w1.x; sel[5] += h * w1.y; sel[6] += h * w1.z; sel[7] += h * w1.w;
    }
    {   const float4 be0 = ((const float4*)(bre + gi * 8))[0], be1 = ((const float4*)(bre + gi * 8))[1];
        sel[0] = wave_sum(sel[0]) + be0.x; sel[1] = wave_sum(sel[1]) + be0.y; sel[2] = wave_sum(sel[2]) + be0.z; sel[3] = wave_sum(sel[3]) + be0.w;
        sel[4] = wave_sum(sel[4]) + be1.x; sel[5] = wave_sum(sel[5]) + be1.y; sel[6] = wave_sum(sel[6]) + be1.z; sel[7] = wave_sum(sel[7]) + be1.w; }
    LDS_WAIT();
    int i1 = 0; float m1 = sel[0];
#pragma unroll
    for (int jj = 1; jj < 8; ++jj) if (sel[jj] > m1) { m1 = sel[jj]; i1 = jj; }
    int i2 = -1; float m2 = -3.0e38f;
#pragma unroll
    for (int jj = 0; jj < 8; ++jj) if (jj != i1 && sel[jj] > m2) { m2 = sel[jj]; i2 = jj; }
    const float e2 = __expf(m2 - m1), w1 = ptop / (1.f + e2), w2 = ptop * e2 / (1.f + e2);
    if (!DISPATCH) { asm volatile("" :: "v"(w1), "v"(w2), "v"(i1), "v"(i2)); return; }
    if (lane == 0) { res[0] = gi * 8 + i1; res[1] = gi * 8 + i2; res[2] = __float_as_int(w1); res[3] = __float_as_int(w2); }
}
DEVINL void ln2_row(const P& p, int r, int lane) {
    const float* U = (const float*)(p.ws + WS_U); const bf16_t* Y = (const bf16_t*)(p.ws + WS_Y); const float* g1 = p.in[15]; const float* b1 = p.in[16]; const float* g2 = p.in[24]; const float* b2 = p.in[25];
    const float* rs1 = (const float*)(p.ws + OFF_ROWSTAT1); const float m1 = rs1[2 * r], r1 = rs1[2 * r + 1];
    const float4* up = (const float4*)(U + (size_t)r * DM);
    const uint2* y0 = (const uint2*)(Y + (size_t)(2 * r) * DM); const uint2* y1 = (const uint2*)(Y + (size_t)(2 * r + 1) * DM);
    float4 v[8]; float s = 0.f;
#pragma unroll
    for (int j = 0; j < 8; ++j) {
        const float4 u = up[lane + 64 * j]; const uint2 a = y0[lane + 64 * j], c = y1[lane + 64 * j];
        const float4 gg = ((const float4*)g1)[lane + 64 * j], bb = ((const float4*)b1)[lane + 64 * j];
        v[j].x = ALPHA * ((u.x - m1) * r1 * gg.x + bb.x) + bf_lo(a.x) + bf_lo(c.x); v[j].y = ALPHA * ((u.y - m1) * r1 * gg.y + bb.y) + bf_hi(a.x) + bf_hi(c.x);
        v[j].z = ALPHA * ((u.z - m1) * r1 * gg.z + bb.z) + bf_lo(a.y) + bf_lo(c.y); v[j].w = ALPHA * ((u.w - m1) * r1 * gg.w + bb.w) + bf_hi(a.y) + bf_hi(c.y);
        s += (v[j].x + v[j].y) + (v[j].z + v[j].w);
    }
    const float mean = wave_sum(s) * (1.f / DM); float q = 0.f;
#pragma unroll
    for (int j = 0; j < 8; ++j) { v[j].x -= mean; v[j].y -= mean; v[j].z -= mean; v[j].w -= mean; q += (v[j].x * v[j].x + v[j].y * v[j].y) + (v[j].z * v[j].z + v[j].w * v[j].w); }
    const float rstd = 1.f / sqrtf(wave_sum(q) * (1.f / DM) + LN_EPS);
    float4* op = (float4*)(p.out + (size_t)r * DM);
#pragma unroll
    for (int j = 0; j < 8; ++j) {
        const float4 gg = ((const float4*)g2)[lane + 64 * j], bb = ((const float4*)b2)[lane + 64 * j];
        op[lane + 64 * j] = make_float4(v[j].x * rstd * gg.x + bb.x, v[j].y * rstd * gg.y + bb.y, v[j].z * rstd * gg.z + bb.z, v[j].w * rstd * gg.w + bb.w);
    }
}


typedef unsigned u32x4_t __attribute__((ext_vector_type(4)));
typedef unsigned u32x2_t __attribute__((ext_vector_type(2)));
typedef float f32x4_t __attribute__((ext_vector_type(4)));
DEVINL bf16x8 pack8(const float* v) { u32x4_t w; w.x = cvtpk(v[0], v[1]); w.y = cvtpk(v[2], v[3]); w.z = cvtpk(v[4], v[5]); w.w = cvtpk(v[6], v[7]); return __builtin_bit_cast(bf16x8, w); }
#define MFMA32(a, b, c) __builtin_amdgcn_mfma_f32_32x32x16_bf16((a), (b), (c), 0, 0, 0)
constexpr int SSTR = 136;
constexpr int XSTR = 132;
constexpr int SSD_B = 0, SSD_C = 128 * SSTR * 2, SSD_DT = 2 * 128 * SSTR * 2, SSD_ACS = SSD_DT + 4096, SSD_DTW = SSD_ACS + 4096, SSD_RED = SSD_DTW + 4096, SSD_WV = SSD_RED + 4096, SSD_WV_BYTES = 32 * XSTR * 2;
constexpr size_t S_CHUNK = (size_t)SH * SP * SN;
constexpr int NCH = 65;
constexpr size_t BC_TILE = 128 * 128;

DEVINL void conv_block2(const P& p, int b, int c, int col0, int cch0, LAS bf16_t* dst, int tid) {
    const int cp = tid & 63, seg = tid >> 6, ch = cch0 + 2 * cp;
    const float* cw = p.in[5];
    const f32x2_t w0 = *(const f32x2_t*)(cw + ch), w1 = *(const f32x2_t*)(cw + 3072 + ch), w2 = *(const f32x2_t*)(cw + 2 * 3072 + ch), w3 = *(const f32x2_t*)(cw + 3 * 3072 + ch), bs = *(const f32x2_t*)(p.in[6] + ch);
    const bf16_t* base = (const bf16_t*)(p.ws + WS_ZP) + (size_t)b * LP * NIN + col0 + 2 * cp;
    const int pr0 = 128 * c + 16 * seg - 3;
    unsigned raw[19];
#pragma unroll
    for (int i = 0; i < 19; ++i) { const int q = pr0 + i; raw[i] = *(const unsigned*)(base + (size_t)(q > 0 ? q : 0) * NIN); }
#pragma unroll
    for (int i = 0; i < 16; ++i) {
        const float va = siluf(w0[0] * bf_lo(raw[i]) + w1[0] * bf_lo(raw[i + 1]) + w2[0] * bf_lo(raw[i + 2]) + w3[0] * bf_lo(raw[i + 3]) + bs[0]);
        const float vb = siluf(w0[1] * bf_hi(raw[i]) + w1[1] * bf_hi(raw[i + 1]) + w2[1] * bf_hi(raw[i + 2]) + w3[1] * bf_hi(raw[i + 3]) + bs[1]);
        *(LAS unsigned*)(dst + (16 * seg + i) * SSTR + 2 * cp) = cvtpk(va, vb);
    }
}
DEVINL void stage_xT(const P& p, int b, int c, int h, int pt, LAS bf16_t* XT, int lane) {
    const int cp = lane & 15, seg = lane >> 4, ch = h * 64 + pt * 32 + 2 * cp;
    const float* cw = p.in[5];
    const f32x2_t w0 = *(const f32x2_t*)(cw + ch), w1 = *(const f32x2_t*)(cw + 3072 + ch), w2 = *(const f32x2_t*)(cw + 2 * 3072 + ch), w3 = *(const f32x2_t*)(cw + 3 * 3072 + ch), bs = *(const f32x2_t*)(p.in[6] + ch);
    const bf16_t* base = (const bf16_t*)(p.ws + WS_ZP) + (size_t)b * LP * NIN + C_X + ch;
    const int pr0 = 128 * c + 32 * seg - 3;
    unsigned raw[35];
#pragma unroll
    for (int i = 0; i < 35; ++i) { const int q = pr0 + i; raw[i] = *(const unsigned*)(base + (size_t)(q > 0 ? q : 0) * NIN); }
#pragma unroll
    for (int i = 0; i < 32; i += 2) {
        float va[2], vb[2];
#pragma unroll
        for (int e = 0; e < 2; ++e) {
            va[e] = siluf(w0[0] * bf_lo(raw[i + e]) + w1[0] * bf_lo(raw[i + e + 1]) + w2[0] * bf_lo(raw[i + e + 2]) + w3[0] * bf_lo(raw[i + e + 3]) + bs[0]);
            vb[e] = siluf(w0[1] * bf_hi(raw[i + e]) + w1[1] * bf_hi(raw[i + e + 1]) + w2[1] * bf_hi(raw[i + e + 2]) + w3[1] * bf_hi(raw[i + e + 3]) + bs[1]);
        }
        const int sidx = 32 * seg + i;
        *(LAS unsigned*)(XT + (2 * cp) * XSTR + sidx) = cvtpk(va[0], va[1]);
        *(LAS unsigned*)(XT + (2 * cp + 1) * XSTR + sidx) = cvtpk(vb[0], vb[1]);
    }
    LDS_WAIT();
}
DEVINL void conv_pre_item(const P& p, int b, int c, int g, LAS unsigned char* lds, int tid, int w, int lane) {
    asm volatile("" : "+v"(tid)); asm volatile("" : "+s"(w)); lane = tid & 63;
    const int bc = b * NCH + c, h = g * 8 + w;
    LAS bf16_t* Bc = (LAS bf16_t*)(lds + SSD_B); LAS bf16_t* Cc = (LAS bf16_t*)(lds + SSD_C);
    __syncthreads();
    conv_block2(p, b, c, C_B + g * 128, 2048 + g * 128, Bc, tid);
    conv_block2(p, b, c, C_C + g * 128, 2560 + g * 128, Cc, tid);
    LAS bf16_t* XT = (LAS bf16_t*)(lds + SSD_WV + w * SSD_WV_BYTES);
#pragma unroll 1
    for (int pt = 0; pt < 2; ++pt) {
        stage_xT(p, b, c, h, pt, XT, lane);
        bf16_t* dst = (bf16_t*)(p.ws + WS_XCT) + ((size_t)(bc * SH + h) * SP + pt * 32) * 128;
#pragma unroll
        for (int k = 0; k < 8; ++k) { const int idx = lane + 64 * k, row = idx >> 4, j = idx & 15;
            const u32x2_t a = *(const LAS u32x2_t*)(XT + row * XSTR + j * 8), bq = *(const LAS u32x2_t*)(XT + row * XSTR + j * 8 + 4);
            *(u32x4_t*)(dst + row * 128 + j * 8) = (u32x4_t){a.x, a.y, bq.x, bq.y}; }
        LDS_WAIT();
    }
    LDS_WAIT();
    __syncthreads();
    const size_t tile = (size_t)(bc * SG + g) * BC_TILE;
    bf16_t* BCg = (bf16_t*)(p.ws + WS_BCC) + tile; bf16_t* CCg = (bf16_t*)(p.ws + WS_CCC) + tile; bf16_t* BTg = (bf16_t*)(p.ws + WS_BTT) + tile;
#pragma unroll
    for (int k = 0; k < 4; ++k) { const int idx = tid + 512 * k, l = idx >> 4, j = idx & 15;
        *(u32x4_t*)(BCg + l * 128 + j * 8) = *(const LAS u32x4_t*)(Bc + l * SSTR + j * 8);
        *(u32x4_t*)(CCg + l * 128 + j * 8) = *(const LAS u32x4_t*)(Cc + l * SSTR + j * 8); }
#pragma unroll
    for (int k = 0; k < 4; ++k) { const int idx = tid + 512 * k, n = idx >> 4, lc = idx & 15;
        unsigned short e[8];
#pragma unroll
        for (int q = 0; q < 8; ++q) e[q] = Bc[(8 * lc + q) * SSTR + n];
        *(u32x4_t*)(BTg + n * 128 + 8 * lc) = (u32x4_t){(unsigned)e[0] | ((unsigned)e[1] << 16), (unsigned)e[2] | ((unsigned)e[3] << 16), (unsigned)e[4] | ((unsigned)e[5] << 16), (unsigned)e[6] | ((unsigned)e[7] << 16)}; }
    asm volatile("s_waitcnt vmcnt(0)" ::: "memory");
}
DEVINL void conv_c64_piece(const P& p, int piece, LAS unsigned char* lds, int w, int lane) {
    if (piece < 128) {
        const int b = piece >> 6, h = (piece >> 1) & 31, pt = piece & 1, bc = b * NCH + 64;
        LAS bf16_t* XT = (LAS bf16_t*)(lds + SSD_WV + w * SSD_WV_BYTES);
        stage_xT(p, b, 64, h, pt, XT, lane);
        bf16_t* dst = (bf16_t*)(p.ws + WS_XCT) + ((size_t)(bc * SH + h) * SP + pt * 32) * 128;
#pragma unroll
        for (int k = 0; k < 8; ++k) { const int idx = lane + 64 * k, row = idx >> 4, j = idx & 15;
            const u32x2_t a = *(const LAS u32x2_t*)(XT + row * XSTR + j * 8), bq = *(const LAS u32x2_t*)(XT + row * XSTR + j * 8 + 4);
            *(u32x4_t*)(dst + row * 128 + j * 8) = (u32x4_t){a.x, a.y, bq.x, bq.y}; }
        LDS_WAIT();
    } else {
        const int q = piece - 128, seg = q & 7, which = (q >> 3) & 1, g = (q >> 4) & 3, b = q >> 6, bc = b * NCH + 64;
        const int col0 = (which ? C_C : C_B) + g * 128, ch = (which ? 2560 : 2048) + g * 128 + 2 * lane;
        const float* cw = p.in[5];
        const f32x2_t w0 = *(const f32x2_t*)(cw + ch), w1 = *(const f32x2_t*)(cw + 3072 + ch), w2 = *(const f32x2_t*)(cw + 2 * 3072 + ch), w3 = *(const f32x2_t*)(cw + 3 * 3072 + ch), bs = *(const f32x2_t*)(p.in[6] + ch);
        const bf16_t* base = (const bf16_t*)(p.ws + WS_ZP) + (size_t)b * LP * NIN + col0 + 2 * lane;
        const int pr0 = 128 * 64 + 16 * seg - 3;
        unsigned raw[19];
#pragma unroll
        for (int i = 0; i < 19; ++i) raw[i] = *(const unsigned*)(base + (size_t)(pr0 + i) * NIN);
        bf16_t* dst = (bf16_t*)(p.ws + (which ? WS_CCC : WS_BCC)) + (size_t)(bc * SG + g) * BC_TILE + (size_t)(16 * seg) * 128 + 2 * lane;
#pragma unroll
        for (int i = 0; i < 16; ++i) {
            const float va = siluf(w0[0] * bf_lo(raw[i]) + w1[0] * bf_lo(raw[i + 1]) + w2[0] * bf_lo(raw[i + 2]) + w3[0] * bf_lo(raw[i + 3]) + bs[0]);
            const float vb = siluf(w0[1] * bf_hi(raw[i]) + w1[1] * bf_hi(raw[i + 1]) + w2[1] * bf_hi(raw[i + 2]) + w3[1] * bf_hi(raw[i + 3]) + bs[1]);
            *(unsigned*)(dst + i * 128) = cvtpk(va, vb);
        }
    }
}
DEVINL void dt_scan(const P& p, int b, int c, int h, int w, int lane, LAS unsigned char* lds) {
    const bf16_t* ZP = (const bf16_t*)(p.ws + WS_ZP);
    const float dtb = p.in[7][h], a = -__expf(p.in[8][h]);
    LAS float* DT = (LAS float*)(lds + SSD_DT) + w * 128; LAS float* ACS = (LAS float*)(lds + SSD_ACS) + w * 128;
    float dt[2], cs[2];
#pragma unroll
    for (int k = 0; k < 2; ++k) { const int l = lane + 64 * k, pr = 128 * c + l;
        const float raw = bf2f(ZP[((size_t)b * LP + pr) * NIN + C_DT + h]) + dtb;
        dt[k] = (pr < 112) ? 0.f : (raw > 20.f ? raw : log1pf(__expf(raw))); cs[k] = dt[k] * a; }
#pragma unroll
    for (int d = 1; d < 64; d <<= 1) { const float t0 = __shfl_up(cs[0], d), t1 = __shfl_up(cs[1], d); if (lane >= d) { cs[0] += t0; cs[1] += t1; } }
    cs[1] += __shfl(cs[0], 63);
    DT[lane] = dt[0]; DT[lane + 64] = dt[1]; ACS[lane] = cs[0]; ACS[lane + 64] = cs[1];
    LDS_WAIT();
}

DEVINL void ssd1_item(const P& p, int item, LAS unsigned char* lds, int tid, int w, int lane) {
    asm volatile("" : "+v"(tid)); asm volatile("" : "+s"(w)); lane = tid & 63;
    const int g = item & 3, c = (item >> 2) & 63, b = item >> 8, h = g * 8 + w, half = lane >> 5, l31 = lane & 31, bc = b * NCH + c;
    LAS bf16_t* BcT = (LAS bf16_t*)(lds + SSD_B);
    __syncthreads();
    {   const bf16_t* BTg = (const bf16_t*)(p.ws + WS_BTT) + (size_t)(bc * SG + g) * BC_TILE;
#pragma unroll
        for (int k = 0; k < 4; ++k) { const int idx = tid + 512 * k, n = idx >> 4, j = idx & 15; *(LAS u32x4_t*)(BcT + n * SSTR + j * 8) = *(const u32x4_t*)(BTg + n * 128 + j * 8); } }
    dt_scan(p, b, c, h, w, lane, lds);
    LAS float* DT = (LAS float*)(lds + SSD_DT) + w * 128; LAS float* ACS = (LAS float*)(lds + SSD_ACS) + w * 128; LAS float* DTW = (LAS float*)(lds + SSD_DTW) + w * 128;
    const float aend = ACS[127];
    DTW[lane] = DT[lane] * __expf(aend - ACS[lane]); DTW[lane + 64] = DT[lane + 64] * __expf(aend - ACS[lane + 64]);
    if (lane == 0) ((float*)(p.ws + OFF_CD))[(b * 64 + c) * SH + h] = __expf(aend);
    LDS_WAIT();
    __syncthreads();
#pragma unroll 1
    for (int pt = 0; pt < 2; ++pt) {
        const bf16_t* xrow = (const bf16_t*)(p.ws + WS_XCT) + ((size_t)(bc * SH + h) * SP + pt * 32 + l31) * 128;
        f32x16 acc[4];
#pragma unroll
        for (int nt = 0; nt < 4; ++nt)
#pragma unroll
            for (int r = 0; r < 16; ++r) acc[nt][r] = 0.f;
#pragma unroll 4
        for (int ks = 0; ks < 8; ++ks) {
            const int lb = ks * 16 + 8 * half;
            const u32x4_t xr = *(const u32x4_t*)(xrow + lb);
            const f32x4_t d0 = *(const LAS f32x4_t*)(DTW + lb), d1 = *(const LAS f32x4_t*)(DTW + lb + 4);
            u32x4_t xs; xs.x = cvtpk(bf_lo(xr.x) * d0[0], bf_hi(xr.x) * d0[1]); xs.y = cvtpk(bf_lo(xr.y) * d0[2], bf_hi(xr.y) * d0[3]);
            xs.z = cvtpk(bf_lo(xr.z) * d1[0], bf_hi(xr.z) * d1[1]); xs.w = cvtpk(bf_lo(xr.w) * d1[2], bf_hi(xr.w) * d1[3]);
            const bf16x8 af = __builtin_bit_cast(bf16x8, xs);
#pragma unroll
            for (int nt = 0; nt < 4; ++nt) { const bf16x8 bfm = *(const LAS bf16x8*)(BcT + (nt * 32 + l31) * SSTR + lb); acc[nt] = MFMA32(af, bfm, acc[nt]); }
        }
        bf16_t* S = (bf16_t*)(p.ws + WS_SST) + ((size_t)(b * 64 + c) * SH + h) * (SP * SN);
#pragma unroll
        for (int nt = 0; nt < 4; ++nt)
#pragma unroll
            for (int r = 0; r < 16; r += 2) { const int pp = pt * 32 + (r & 3) + 8 * (r >> 2) + 4 * half; const unsigned cv = cvtpk(acc[nt][r], acc[nt][r + 1]);
                S[pp * SN + nt * 32 + l31] = (bf16_t)(cv & 0xffffu); S[(pp + 1) * SN + nt * 32 + l31] = (bf16_t)(cv >> 16); }
    }
}
DEVINL void ssd2_scan(const P& p, int gt) {
    const size_t e = (size_t)gt * 4; if (e >= 2 * S_CHUNK) return;
    const int b = (int)(e / S_CHUNK); const size_t rem = e % S_CHUNK; const int h = (int)(rem >> 13);
    const bf16_t* S = (const bf16_t*)(p.ws + WS_SST); bf16_t* PV = (bf16_t*)(p.ws + WS_PREV); const float* CD = (const float*)(p.ws + OFF_CD);
    float s0 = 0.f, s1 = 0.f, s2 = 0.f, s3 = 0.f;
#pragma unroll 8
    for (int c = 0; c < 64; ++c) {
        const size_t off = (size_t)(b * 64 + c) * S_CHUNK + rem;
        const uint2 v = *(const uint2*)(S + off); const float cd = CD[(b * 64 + c) * SH + h];
        s0 = s0 * cd + bf_lo(v.x); s1 = s1 * cd + bf_hi(v.x); s2 = s2 * cd + bf_lo(v.y); s3 = s3 * cd + bf_hi(v.y);
        *(uint2*)(PV + off) = make_uint2(cvtpk(s0, s1), cvtpk(s2, s3));
    }
}
DEVINL void ssd3_item(const P& p, int item, LAS unsigned char* lds, int tid, int w, int lane) {
    asm volatile("" : "+v"(tid)); asm volatile("" : "+s"(w)); lane = tid & 63;
    const int g = item & 3, c = ((item >> 2) & 63) + 1, b = item >> 8, h = g * 8 + w, half = lane >> 5, l31 = lane & 31, bc = b * NCH + c;
    LAS bf16_t* Bc = (LAS bf16_t*)(lds + SSD_B); LAS bf16_t* Cc = (LAS bf16_t*)(lds + SSD_C);
    __syncthreads();
    {   const size_t tile = (size_t)(bc * SG + g) * BC_TILE;
        const bf16_t* BCg = (const bf16_t*)(p.ws + WS_BCC) + tile; const bf16_t* CCg = (const bf16_t*)(p.ws + WS_CCC) + tile;
#pragma unroll
        for (int k = 0; k < 4; ++k) { const int idx = tid + 512 * k, l = idx >> 4, j = idx & 15;
            *(LAS u32x4_t*)(Bc + l * SSTR + j * 8) = *(const u32x4_t*)(BCg + l * 128 + j * 8);
            *(LAS u32x4_t*)(Cc + l * SSTR + j * 8) = *(const u32x4_t*)(CCg + l * 128 + j * 8); } }
    dt_scan(p, b, c, h, w, lane, lds);
    LAS float* DT = (LAS float*)(lds + SSD_DT) + w * 128; LAS float* ACS = (LAS float*)(lds + SSD_ACS) + w * 128;
    __syncthreads();
    const bf16_t* ZP = (const bf16_t*)(p.ws + WS_ZP);
    const bf16_t* PV = (const bf16_t*)(p.ws + WS_PREV) + ((size_t)(b * 64 + c - 1) * SH + h) * (SP * SN);
    const bf16_t* xrow = (const bf16_t*)(p.ws + WS_XCT) + ((size_t)(bc * SH + h) * SP + l31) * 128;
    const float dsk = p.in[9][h];
    f32x16 acc[2][4];
#pragma unroll
    for (int pt = 0; pt < 2; ++pt)
#pragma unroll
        for (int lt = 0; lt < 4; ++lt)
#pragma unroll
            for (int r = 0; r < 16; ++r) acc[pt][lt][r] = 0.f;
#pragma unroll 2
    for (int kn = 0; kn < 8; ++kn) {
        const int nb = kn * 16 + 8 * half;
        const bf16x8 a0 = *(const bf16x8*)(PV + (size_t)l31 * SN + nb), a1 = *(const bf16x8*)(PV + (size_t)(32 + l31) * SN + nb);
#pragma unroll
        for (int lt = 0; lt < 4; ++lt) { const bf16x8 cf = *(const LAS bf16x8*)(Cc + (lt * 32 + l31) * SSTR + nb); acc[0][lt] = MFMA32(a0, cf, acc[0][lt]); acc[1][lt] = MFMA32(a1, cf, acc[1][lt]); }
    }
#pragma unroll
    for (int lt = 0; lt < 4; ++lt) { const float ea = __expf(ACS[lt * 32 + l31]);
#pragma unroll
        for (int r = 0; r < 16; ++r) { acc[0][lt][r] *= ea; acc[1][lt][r] *= ea; } }
#pragma unroll 1
    for (int st = 0; st < 4; ++st) {
        int dd = l31 - 4 * half; asm volatile("" : "+v"(dd));
        bf16x8 xa[2][2];
#pragma unroll
        for (int pt = 0; pt < 2; ++pt)
#pragma unroll
            for (int ks = 0; ks < 2; ++ks) { const int s0 = st * 32 + 16 * ks + 4 * half;
                const u32x2_t x0 = *(const u32x2_t*)(xrow + pt * 32 * 128 + s0), x1 = *(const u32x2_t*)(xrow + pt * 32 * 128 + s0 + 8);
                xa[pt][ks] = __builtin_bit_cast(bf16x8, ((u32x4_t){x0.x, x0.y, x1.x, x1.y})); }
#pragma unroll
        for (int lt = 0; lt < 4; ++lt) { if (lt < st) continue;
            f32x16 ga;
#pragma unroll
            for (int r = 0; r < 16; ++r) ga[r] = 0.f;
#pragma unroll
            for (int kn = 0; kn < 8; ++kn) {
                const int nb = kn * 16 + 8 * half;
                const bf16x8 bfm = *(const LAS bf16x8*)(Bc + (st * 32 + l31) * SSTR + nb), cf = *(const LAS bf16x8*)(Cc + (lt * 32 + l31) * SSTR + nb);
                ga = MFMA32(bfm, cf, ga);
            }
            float mv[16]; const float acl = ACS[lt * 32 + l31];
#pragma unroll
            for (int q = 0; q < 4; ++q) { const f32x4_t a4 = *(const LAS f32x4_t*)(ACS + st * 32 + 8 * q + 4 * half), d4 = *(const LAS f32x4_t*)(DT + st * 32 + 8 * q + 4 * half);
#pragma unroll
                for (int i = 0; i < 4; ++i) { const int r = 4 * q + i;
                    float v = ga[r] * __expf(fminf(acl - a4[i], 0.f)) * d4[i];
                    if (lt == st) { v = (8 * q + i <= dd) ? v : 0.f; v += (8 * q + i == dd) ? dsk : 0.f; }
                    mv[r] = v; } }
            const bf16x8 b0 = pack8(mv), b1 = pack8(mv + 8);
            acc[0][lt] = MFMA32(xa[0][0], b0, acc[0][lt]); acc[1][lt] = MFMA32(xa[1][0], b0, acc[1][lt]);
            acc[0][lt] = MFMA32(xa[0][1], b1, acc[0][lt]); acc[1][lt] = MFMA32(xa[1][1], b1, acc[1][lt]);
        }
    }
    LAS bf16_t* ZT = (LAS bf16_t*)(lds + SSD_WV + w * SSD_WV_BYTES);
    const int rr = lane >> 2, cq = lane & 3;
    float ssq[4];
#pragma unroll
    for (int lt = 0; lt < 4; ++lt) ssq[lt] = 0.f;
#pragma unroll
    for (int pt = 0; pt < 2; ++pt) {
#pragma unroll
        for (int k0 = 0; k0 < 8; k0 += 4) {
            u32x4_t zl[4];
#pragma unroll
            for (int k = 0; k < 4; ++k) zl[k] = *(const u32x4_t*)(ZP + ((size_t)b * LP + 128 * c + rr + 16 * (k0 + k)) * NIN + C_Z + h * 64 + pt * 32 + cq * 8);
#pragma unroll
            for (int k = 0; k < 4; ++k) *(LAS u32x4_t*)(ZT + (rr + 16 * (k0 + k)) * 32 + cq * 8) = zl[k];
        }
        LDS_WAIT();
#pragma unroll
        for (int lt = 0; lt < 4; ++lt) {
            float sq = 0.f;
#pragma unroll
            for (int q = 0; q < 4; ++q) { const u32x2_t z4 = *(const LAS u32x2_t*)(ZT + (lt * 32 + l31) * 32 + 8 * q + 4 * half);
                const float y0 = acc[pt][lt][4 * q] * siluf(bf_lo(z4.x)), y1 = acc[pt][lt][4 * q + 1] * siluf(bf_hi(z4.x)), y2 = acc[pt][lt][4 * q + 2] * siluf(bf_lo(z4.y)), y3 = acc[pt][lt][4 * q + 3] * siluf(bf_hi(z4.y));
                acc[pt][lt][4 * q] = y0; acc[pt][lt][4 * q + 1] = y1; acc[pt][lt][4 * q + 2] = y2; acc[pt][lt][4 * q + 3] = y3;
                sq += (y0 * y0 + y1 * y1) + (y2 * y2 + y3 * y3); }
            ssq[lt] += sq;
        }
        LDS_WAIT();
    }
#pragma unroll
    for (int lt = 0; lt < 4; ++lt) ssq[lt] += __shfl_xor(ssq[lt], 32);
    LAS float* RED = (LAS float*)(lds + SSD_RED);
    if (half == 0) {
#pragma unroll
        for (int lt = 0; lt < 4; ++lt) RED[w * 128 + lt * 32 + l31] = ssq[lt];
    }
    LDS_WAIT();
    __syncthreads();
    float rstd[4];
#pragma unroll
    for (int lt = 0; lt < 4; ++lt) { float tot = 0.f;
#pragma unroll
        for (int ww = 0; ww < 8; ++ww) tot += RED[ww * 128 + lt * 32 + l31];
        rstd[lt] = 1.f / sqrtf(tot * (1.f / 512.f) + RMS_EPS); }
    const float* ng = p.in[10];
    bf16_t* AY = (bf16_t*)(p.ws + WS_AY);
#pragma unroll
    for (int pt = 0; pt < 2; ++pt) {
#pragma unroll
        for (int q = 0; q < 4; ++q) { const f32x4_t g4 = *(const f32x4_t*)(ng + h * 64 + pt * 32 + 8 * q + 4 * half);
#pragma unroll
            for (int lt = 0; lt < 4; ++lt)
                *(LAS u32x2_t*)(ZT + (lt * 32 + l31) * 32 + 8 * q + 4 * half) = (u32x2_t){cvtpk(acc[pt][lt][4 * q] * rstd[lt] * g4[0], acc[pt][lt][4 * q + 1] * rstd[lt] * g4[1]), cvtpk(acc[pt][lt][4 * q + 2] * rstd[lt] * g4[2], acc[pt][lt][4 * q + 3] * rstd[lt] * g4[3])}; }
        LDS_WAIT();
#pragma unroll
        for (int k = 0; k < 8; ++k) *(u32x4_t*)(AY + ((size_t)b * SEQ + 128 * (c - 1) + rr + 16 * k) * 3072 + 1024 + h * 64 + pt * 32 + cq * 8) = *(const LAS u32x4_t*)(ZT + (rr + 16 * k) * 32 + cq * 8);
        LDS_WAIT();
    }
}

constexpr int AT_KSTR = 72;
constexpr int AT_VSTR = 388;
constexpr int AT_K = 0, AT_V = 288 * AT_KSTR * 2;
DEVINL void attn_mfma_item(const P& p, int item, LAS unsigned char* lds, int tid, int w, int lane) {
    asm volatile("" : "+v"(tid)); asm volatile("" : "+s"(w)); lane = tid & 63;
    const int n = (item & 63) + 1, kvh = (item >> 6) & 3, b = item >> 8, half = lane >> 5, l31 = lane & 31;
    const bf16_t* ZP = (const bf16_t*)(p.ws + WS_ZP);
    LAS bf16_t* Kl = (LAS bf16_t*)(lds + AT_K); LAS bf16_t* Vt = (LAS bf16_t*)(lds + AT_V);
    __syncthreads();
    for (int ci = tid; ci < 288 * 8; ci += 512) {
        const int kk = ci >> 3, dc = ci & 7;
        u32x4_t kv = (u32x4_t){0u, 0u, 0u, 0u}, vv = (u32x4_t){0u, 0u, 0u, 0u};
        if (kk < 272) { const int pr = kk < 256 ? 128 * (n - 1) + kk : 112 + (kk - 256);
            const bf16_t* rp = ZP + ((size_t)b * LP + pr) * NIN + kvh * 64 + dc * 8;
            kv = *(const u32x4_t*)(rp + C_K); vv = *(const u32x4_t*)(rp + C_V); }
        *(LAS u32x4_t*)(Kl + kk * AT_KSTR + dc * 8) = kv;
        LAS bf16_t* vd = Vt + (dc * 8) * AT_VSTR + kk;
        vd[0] = (bf16_t)(vv.x & 0xffffu); vd[AT_VSTR] = (bf16_t)(vv.x >> 16); vd[2 * AT_VSTR] = (bf16_t)(vv.y & 0xffffu); vd[3 * AT_VSTR] = (bf16_t)(vv.y >> 16);
        vd[4 * AT_VSTR] = (bf16_t)(vv.z & 0xffffu); vd[5 * AT_VSTR] = (bf16_t)(vv.z >> 16); vd[6 * AT_VSTR] = (bf16_t)(vv.w & 0xffffu); vd[7 * AT_VSTR] = (bf16_t)(vv.w >> 16);
    }
    LDS_WAIT();
    __syncthreads();
    const int g = w >> 1, qh = w & 1, hq = kvh * 4 + g;
    const float sink = p.in[11][hq];
    bf16_t* AY = (bf16_t*)(p.ws + WS_AY);
#pragma unroll 1
    for (int q2 = 0; q2 < 2; ++q2) {
        const int qt = 2 * qh + q2;
        const bf16_t* qp = ZP + ((size_t)b * LP + 128 * n + 32 * qt + l31) * NIN + C_Q + hq * 64 + 8 * half;
        bf16x8 qf[4];
#pragma unroll
        for (int ks = 0; ks < 4; ++ks) qf[ks] = *(const bf16x8*)(qp + ks * 16);
        f32x16 o0, o1;
#pragma unroll
        for (int r = 0; r < 16; ++r) { o0[r] = 0.f; o1[r] = 0.f; }
        float m = sink, lsum = (half == 0) ? 1.f : 0.f;
        const int iq = 32 * qt + l31;
#pragma unroll 1
        for (int t = 0; t < 6; ++t) {
            const int jt = (t < 5) ? qt + t : 8;
            if (n == 1 && jt < 4) continue;
            f32x16 st;
#pragma unroll
            for (int r = 0; r < 16; ++r) st[r] = 0.f;
#pragma unroll
            for (int ks = 0; ks < 4; ++ks) { const bf16x8 kf = *(const LAS bf16x8*)(Kl + (jt * 32 + l31) * AT_KSTR + ks * 16 + 8 * half); st = MFMA32(kf, qf[ks], st); }
            float tmax = -1e30f;
#pragma unroll
            for (int r = 0; r < 16; ++r) { const int kk = jt * 32 + (r & 3) + 8 * (r >> 2) + 4 * half;
                const bool ok = (jt == 8) ? (kk < 272) : (kk >= iq + 1 && kk <= iq + 128);
                st[r] = ok ? st[r] * 0.125f : -1e30f; tmax = fmaxf(tmax, st[r]); }
            tmax = fmaxf(tmax, __shfl_xor(tmax, 32));
            const float mn = fmaxf(m, tmax), al = __expf(m - mn);
            float ps = 0.f; float pv[16];
#pragma unroll
            for (int r = 0; r < 16; ++r) { pv[r] = __expf(st[r] - mn); ps += pv[r]; }
            lsum = lsum * al + ps; m = mn;
#pragma unroll
            for (int r = 0; r < 16; ++r) { o0[r] *= al; o1[r] *= al; }
            const bf16x8 pb0 = pack8(pv), pb1 = pack8(pv + 8);
#pragma unroll
            for (int s2 = 0; s2 < 2; ++s2) {
                const LAS bf16_t* v0 = Vt + l31 * AT_VSTR + jt * 32 + 16 * s2 + 4 * half; const LAS bf16_t* v1 = v0 + 32 * AT_VSTR;
                const u32x2_t a00 = *(const LAS u32x2_t*)(v0), a01 = *(const LAS u32x2_t*)(v0 + 8), a10 = *(const LAS u32x2_t*)(v1), a11 = *(const LAS u32x2_t*)(v1 + 8);
                const u32x4_t A0 = (u32x4_t){a00.x, a00.y, a01.x, a01.y}, A1 = (u32x4_t){a10.x, a10.y, a11.x, a11.y};
                o0 = MFMA32(__builtin_bit_cast(bf16x8, A0), s2 == 0 ? pb0 : pb1, o0);
                o1 = MFMA32(__builtin_bit_cast(bf16x8, A1), s2 == 0 ? pb0 : pb1, o1);
            }
        }
        lsum += __shfl_xor(lsum, 32);
        const float il = 1.f / lsum;
        const size_t orow = ((size_t)b * SEQ + 128 * (n - 1) + 32 * qt + l31) * 3072 + hq * 64;
#pragma unroll
        for (int q = 0; q < 4; ++q) {
            *(uint2*)(AY + orow + 8 * q + 4 * half) = make_uint2(cvtpk(o0[4 * q] * il, o0[4 * q + 1] * il), cvtpk(o0[4 * q + 2] * il, o0[4 * q + 3] * il));
            *(uint2*)(AY + orow + 32 + 8 * q + 4 * half) = make_uint2(cvtpk(o1[4 * q] * il, o1[4 * q + 1] * il), cvtpk(o1[4 * q + 2] * il, o1[4 * q + 3] * il));
        }
    }
}

constexpr int LDS_BYTES = 163840, CTLZ_OFF = LDS_BYTES - 1024, MISC_OFF = CTLZ_OFF + 320;
static_assert(SSD_WV + 8 * SSD_WV_BYTES <= CTLZ_OFF && AT_V + 64 * AT_VSTR * 2 <= CTLZ_OFF && pg8::STAGE_BYTES <= CTLZ_OFF, "LDS map");
constexpr int NPHASE = 11;
__global__ void __launch_bounds__(512, 2) mega_fwd(P p) {
    extern __shared__ __attribute__((aligned(16))) unsigned char lds_raw[];
    LAS unsigned char* lds = (LAS unsigned char*)lds_raw;
    volatile LAS unsigned* MISC = (volatile LAS unsigned*)(lds + MISC_OFF);
    const int tid = threadIdx.x, lane = tid & 63, wave = __builtin_amdgcn_readfirstlane(tid >> 6);
    const int G = gridDim.x, bx = blockIdx.x;
    const int vcu = (G % 8 == 0) ? (bx % 8) * (G / 8) + bx / 8 : bx;
    const int gw = bx * 8 + wave, NGW = G * 8;
    unsigned char* ws = p.ws;
    for (int u = tid; u < (LDS_BYTES - CTLZ_OFF) / 4; u += 512) ((LAS unsigned*)(lds + CTLZ_OFF))[u] = 0u;
    __syncthreads();
    const bool one_launch = (p.ph_hi - p.ph_lo) > 1;
    XcdBarrier bar; bar.bar = (unsigned*)(ws + WS_CTL); bar.x = 0; bar.st = nullptr;
    if (one_launch) bar = xcd_barrier_post((unsigned*)(ws + WS_CTL), MISC + 8);
#ifndef PHASE_MASK
#define PHASE_MASK 0xFFFF
#endif
#define IN(k) (((PHASE_MASK >> (k)) & 1) && p.ph_lo <= (k) && (k) < p.ph_hi)
#define SEAM(k) do { if (IN(k) && IN((k) + 1)) xcd_barrier(bar); } while (0)
#define REP(k) for (int rep_ = 0; rep_ < 1 + ((REPEAT_MASK >> (k)) & 1); ++rep_, (void)((rep_ < 1 + ((REPEAT_MASK >> (k)) & 1)) ? (xcd_barrier(bar), 0) : 0))

    if (IN(0)) REP(0) {
        {   constexpr int NDENSE_ITEMS = 32 * 344 + 16 * 64 + 32 * 64 + 32 * 64;
            const int niter = (MP + NGW - 1) / NGW, tpw = (NDENSE_ITEMS + NGW - 1) / NGW, tpi = (tpw + niter - 1) / niter;
            for (int i = 0; i < niter; ++i) {
                const int R = gw + i * NGW; if (R < MP) ln0_row(p, R, lane);
                phase_weights(p, (LAS float*)(lds + wave * 16384), gw, NGW, lane, false, i * tpi * NGW, (i + 1) * tpi * NGW);
            } }
        for (int idx = bx * 512 + tid; idx < DM * NE; idx += G * 512) { const int i = idx >> 6, cc = idx & 63; ((float*)(ws + OFF_WREG))[((cc >> 3) * DM + i) * 8 + (cc & 7)] = p.in[19][idx]; }
    }
    SEAM(0);
    for (int eb_ = 0; eb_ < EXTRA_BARRIERS; ++eb_) xcd_barrier(bar);
    if (IN(1)) REP(1) {
        pg8::Gemm g{(const bf16_t*)(ws + WS_H0), (const bf16_t*)(ws + WS_WIN), DM, DM, DM};
        pg8::StaticOrder S; S.init(g, MP, NIN, G, bx, WGM_INPROJ);
        pg8::EpiBf16Plain E{(bf16_t*)(ws + WS_ZP), (size_t)NIN};
        pg8::gemm_phase<pg8::EpiBf16Plain, pg8::StaticOrder, true, false>(lds, g, S, E);
    }
    SEAM(1);
    if (IN(2)) REP(2) {
        for (int pc = gw; pc < 256; pc += NGW) conv_c64_piece(p, pc, lds, wave, lane);
        for (int j = vcu; j < 512; j += G) {
            conv_pre_item(p, j >> 8, (j >> 2) & 63, j & 3, lds, tid, wave, lane);
            ssd1_item(p, j, lds, tid, wave, lane);
        }
        for (int it = vcu; it < 512; it += G) attn_mfma_item(p, it, lds, tid, wave, lane);
    }
    SEAM(2);
    if (IN(3)) REP(3) { for (int gt = bx * 512 + tid; gt < (int)(2 * S_CHUNK / 4); gt += G * 512) ssd2_scan(p, gt); }
    SEAM(3);
    if (IN(4)) REP(4) { for (int it = vcu; it < 512; it += G) ssd3_item(p, it, lds, tid, wave, lane); }
    SEAM(4);
    if (IN(5)) {
        {   pg8::Gemm g{(const bf16_t*)(ws + WS_AY), (const bf16_t*)(ws + WS_WBRA), 3072, 1024, 1024};
            pg8::StaticOrder S; S.init(g, MR, DM, G, bx, WGM_DENSE);
            pg8::EpiBrA E{(bf16_t*)(ws + WS_T1S), (const bf16_t*)(ws + WS_ZP)};
            pg8::gemm_phase<pg8::EpiBrA, pg8::StaticOrder, true, false>(lds, g, S, E); }
        {   pg8::Gemm g{(const bf16_t*)(ws + WS_AY) + 1024, (const bf16_t*)(ws + WS_WBRS), 3072, DM, DM};
            pg8::StaticOrder S; S.init(g, MR, DM, G, bx, WGM_DENSE);
            pg8::EpiBrS E{(const bf16_t*)(ws + WS_T1S), (const bf16_t*)(ws + WS_ZP), (bf16_t*)(ws + WS_MERGED)};
            pg8::gemm_phase<pg8::EpiBrS, pg8::StaticOrder, true, false>(lds, g, S, E); }
    }
    SEAM(5);
    if (IN(6)) {
        pg8::Gemm g{(const bf16_t*)(ws + WS_MERGED), (const bf16_t*)(ws + WS_WO), DM, DM, DM};
        pg8::StaticOrder S; S.init(g, MR, DM, G, bx, WGM_DENSE);
        pg8::EpiWo E{(float*)(ws + WS_U), p.in[0], (const float*)(ws + OFF_ROWSTAT), p.in[2], p.in[3]};
        pg8::gemm_phase<pg8::EpiWo, pg8::StaticOrder, true, false>(lds, g, S, E);
    }
    SEAM(6);
    if (IN(7)) {
        LAS float* wrgl = (LAS float*)(lds + 8 * 8448);
        __syncthreads();
        for (int u = tid; u < DM * 8 / 4; u += 512) *(LAS pg8::f32x4*)(wrgl + 4 * u) = *(const pg8::f32x4*)(p.in[17] + 4 * u);
        LDS_WAIT(); __syncthreads();
        {   const int niter = (MR + NGW - 1) / NGW;
            LAS int* res = (LAS int*)(lds + 8 * 8448 + DM * 8 * 4);
            float4 vin[8];
            if (gw < MR) {
#pragma unroll
                for (int j = 0; j < 8; ++j) vin[j] = ((const float4*)((const float*)(ws + WS_U) + (size_t)gw * DM))[lane + 64 * j]; }
            for (int i = 0; i < niter; ++i) {
                const int r = gw + i * NGW, rn = (i + 1 < niter && r + NGW < MR) ? r + NGW : -1;
                if (r < MR) ln1_router_row<true>(p, r, rn, vin, lane, (LAS float*)(lds + wave * 8448), wrgl, res + (wave * niter + i) * 4);
#if !MOE_WF32
                { constexpr int NMOE_ITEMS = 64 * 32 * 32 + 64 * 8 * 64; const int tpw = (NMOE_ITEMS + NGW - 1) / NGW, tpi = (tpw + niter - 1) / niter;
                  phase_weights(p, (LAS float*)(lds + wave * 8448), gw, NGW, lane, true, i * tpi * NGW, (i + 1) * tpi * NGW); }
#endif
            }
            LAS int* lcnt = (LAS int*)lds; LAS int* lbase = lcnt + 64; LAS int* lp = lcnt + 128;
            int* cnt = (int*)(ws + OFF_CNT); int* list_ent = (int*)(ws + WS_LIST); float* list_w = (float*)(ws + WS_LISTW);
            LDS_WAIT(); __syncthreads();
            if (tid < 64) lcnt[tid] = 0;
            LDS_WAIT(); __syncthreads();
            const int nent = 16 * niter;
            for (int t = tid; t < nent; t += 512) { const int w = t / (2 * niter), i = (t >> 1) % niter, k = t & 1, r = bx * 8 + w + i * NGW;
                if (r < MR) lp[t] = __hip_atomic_fetch_add(lcnt + res[(w * niter + i) * 4 + k], 1, __ATOMIC_RELAXED, __HIP_MEMORY_SCOPE_WORKGROUP); }
            LDS_WAIT(); __syncthreads();
            if (tid < 64) { const int c = lcnt[tid]; lbase[tid] = c ? atomicAdd(&cnt[tid], c) : 0; }
            LDS_WAIT(); __syncthreads();
            for (int t = tid; t < nent; t += 512) { const int w = t / (2 * niter), i = (t >> 1) % niter, k = t & 1, r = bx * 8 + w + i * NGW;
                if (r < MR) { const int e = res[(w * niter + i) * 4 + k], pos = lbase[e] + lp[t];
                    list_ent[e * MR + pos] = r * 2 + k; list_w[e * MR + pos] = __int_as_float(res[(w * niter + i) * 4 + 2 + k]); } }
        }
    }
    SEAM(7);
    LAS int* tl_e = (LAS int*)(lds + 131072); LAS int* tl_f = tl_e + MOE_MAXT; LAS int* tl_n = tl_f + MOE_MAXT; LAS int* tl_x = tl_n + MOE_MAXT;
    if (IN(8) || IN(9)) {
        __syncthreads();
        if (tid < NE) tl_x[tid] = (((const int*)(ws + OFF_CNT))[tid] + MOE_TILE - 1) / MOE_TILE;
        LDS_WAIT(); __syncthreads();
        if (tid < NE) { int st0 = 0; for (int i = 0; i < tid; ++i) st0 += tl_x[i];
            const int cn = ((const int*)(ws + OFF_CNT))[tid], nt = tl_x[tid];
            for (int j = 0; j < nt; ++j) { tl_e[st0 + j] = tid; tl_f[st0 + j] = j * MOE_TILE; tl_n[st0 + j] = (cn - j * MOE_TILE) < MOE_TILE ? (cn - j * MOE_TILE) : MOE_TILE; }
            if (tid == NE - 1) tl_x[64] = st0 + nt; }
        LDS_WAIT(); __syncthreads();
    }
    const pg8::MoeTiles MT{tl_e, tl_f, tl_n, (const int*)(ws + WS_LIST), (const float*)(ws + WS_LISTW)};
    if (IN(8)) REP(8) {
        const int NT = tl_x[64];
        pg8::Gemm g{(const bf16_t*)(ws + WS_H1B), (const bf16_t*)(ws + WS_WGU), DM, DM, DM};
        pg8::MoeOrder S{4, NT * 4, G, vcu, g.A, DM, g.Bt, (size_t)1024 * DM, DM, MT, true};
        pg8::EpiGateUp E{(bf16_t*)(ws + WS_HID)};
#if MOE_WF32
        const pg8::WF32 wf{p.in[21], p.in[22], (size_t)DM * DE, 128, DE};
        pg8::gemm_phase_wf32<pg8::EpiGateUp, pg8::MoeOrder, true, WF32_ROWMAP_GU>(lds, g, S, E, wf);
#else
        pg8::gemm_phase<pg8::EpiGateUp, pg8::MoeOrder, true, true>(lds, g, S, E);
#endif
    }
#if PROBE_P8_TWICE
    xcd_barrier(bar);
    if (IN(8)) {
        const int NT = tl_x[64];
        pg8::Gemm g{(const bf16_t*)(ws + WS_H1B), (const bf16_t*)(ws + WS_WGU), DM, DM, DM};
        pg8::MoeOrder S{4, NT * 4, G, vcu, g.A, DM, g.Bt, (size_t)1024 * DM, DM, MT, true};
        pg8::EpiGateUp E{(bf16_t*)(ws + WS_HID)};
#if MOE_WF32
        const pg8::WF32 wf{p.in[21], p.in[22], (size_t)DM * DE, 128, DE};
        pg8::gemm_phase_wf32<pg8::EpiGateUp, pg8::MoeOrder, true, WF32_ROWMAP_GU>(lds, g, S, E, wf);
#else
        pg8::gemm_phase<pg8::EpiGateUp, pg8::MoeOrder, true, true>(lds, g, S, E);
#endif
    }
#endif
    SEAM(8);
    if (IN(9)) REP(9) {
        const int NT = tl_x[64];
        pg8::Gemm g{(const bf16_t*)(ws + WS_HID), (const bf16_t*)(ws + WS_WDN), DE, DE, DE};
        pg8::MoeOrder S{8, NT * 8, G, vcu, g.A, DE, g.Bt, (size_t)DM * DE, DE, MT, false};
        pg8::EpiDown E{(bf16_t*)(ws + WS_Y), MT};
#if MOE_WF32
        const pg8::WF32 wf{p.in[23], p.in[23] + 128, (size_t)DE * DM, 256, DM};
        pg8::gemm_phase_wf32<pg8::EpiDown, pg8::MoeOrder, false, WF32_ROWMAP_DN>(lds, g, S, E, wf);
#else
        pg8::gemm_phase<pg8::EpiDown, pg8::MoeOrder, true, false>(lds, g, S, E);
#endif
    }
    SEAM(9);
    if (IN(10)) REP(10) { for (int r = gw; r < MR; r += NGW) ln2_row(p, r, lane); }
#undef IN
#undef SEAM
}

extern "C" void kernel_launch(void* const* d_in, const int* in_sizes, int n_in, void* d_out, int out_size, void* d_ws, size_t ws_size, hipStream_t stream) {
    static int grid = 0;
    if (grid == 0) {
        if (n_in != 26 || ws_size < WS_END) { fprintf(stderr, "kernel_launch: unexpected n_in %d or ws_size %zu\n", n_in, ws_size); grid = -1; return; }
        int dev = 0, cus = 0;
        if (hipGetDevice(&dev) != hipSuccess || hipDeviceGetAttribute(&cus, hipDeviceAttributeMultiprocessorCount, dev) != hipSuccess) { grid = -1; return; }
        if (hipFuncSetAttribute((const void*)mega_fwd, hipFuncAttributeMaxDynamicSharedMemorySize, LDS_BYTES) != hipSuccess) { fprintf(stderr, "kernel_launch: hipFuncSetAttribute failed\n"); grid = -1; return; }
        grid = cus;
    }
    if (grid < 0) return;
    (void)hipMemsetAsync((char*)d_ws + WS_CTL, 0, CTL_BYTES, stream);
    P a{};
    for (int i = 0; i < 26; ++i) a.in[i] = (const float*)d_in[i];
    a.out = (float*)d_out; a.ws = (unsigned char*)d_ws;
#if MK_PER_PHASE
    for (int k = 0; k < NPHASE; ++k) { a.ph_lo = k; a.ph_hi = k + 1; hipLaunchKernelGGL(mega_fwd, dim3(grid), dim3(512), LDS_BYTES, stream, a); }
#else
    a.ph_lo = 0; a.ph_hi = NPHASE;
    hipLaunchKernelGGL(mega_fwd, dim3(grid), dim3(512), LDS_BYTES, stream, a);
#endif
}
```

```cpp
#include <hip/hip_runtime.h>
#include <stdint.h>
#include <stdio.h>

typedef unsigned short bf16_t;
typedef short bf16x8 __attribute__((ext_vector_type(8)));
typedef float f32x16 __attribute__((ext_vector_type(16)));
#define DEVINL __device__ __forceinline__
#define LAS __attribute__((address_space(3)))
#define WGM_INPROJ 4
#define WGM_DENSE 4
#define MOE_TAILFILL 1
#define MOE_WF32 1
#define WF32_SP2S_GU false
#define WF32_SP2S_DN true
#define WF32_ROWMAP_GU 7
#define WF32_ROWMAP_DN 7
#define PROBE_P8_TWICE 0
#define REPEAT_MASK 0
#define EXTRA_BARRIERS 0
#ifndef MK_PER_PHASE
#define MK_PER_PHASE 0
#endif

constexpr int BATCH = 2, SEQ = 8192, DM = 2048, NMETA = 16;
constexpr int LP = 8320;
constexpr int MP = BATCH * LP;
constexpr int MR = BATCH * SEQ;
constexpr int NIN = 11008;
constexpr int C_Q = 0, C_K = 1024, C_V = 1280, C_Z = 1536, C_X = 3584, C_B = 5632, C_C = 6144, C_GA = 6656, C_GS = 8704, C_DT = 10752;
constexpr int HQ = 16, HKV = 4, HD = 64;
constexpr int SH = 32, SP = 64, SG = 4, SN = 128;
constexpr int NE = 64, DE = 512;
constexpr int MOE_TILE = 256, MOE_MAXT = 192, MOE_MAXPOS = MOE_MAXT * MOE_TILE;
constexpr float LN_EPS = 1e-5f, RMS_EPS = 1e-5f;
constexpr float ALPHA = 1.189207115002721f;

constexpr size_t MiB = 1ull << 20;
constexpr size_t WS_CTL = 0;
constexpr size_t CTL_BYTES = 1 * MiB;
constexpr size_t OFF_CNT = 64 * 1024;
constexpr size_t OFF_ARR = 64 * 1024 + 8192;
constexpr size_t OFF_SS = 128 * 1024;
constexpr size_t WS_MISC = 1 * MiB;
constexpr size_t OFF_ROWSTAT = WS_MISC;
constexpr size_t OFF_ROWSTAT1 = WS_MISC + 128 * 1024;
constexpr size_t OFF_TILE_E = WS_MISC + 256 * 1024;
constexpr size_t OFF_WREG = WS_MISC + 512 * 1024;
constexpr size_t OFF_NT = WS_MISC + 260 * 1024;
constexpr size_t OFF_CD = WS_MISC + 264 * 1024;
constexpr size_t WS_WIN = 2 * MiB;
constexpr size_t WS_WBRA = 45 * MiB;
constexpr size_t WS_WBRS = 49 * MiB;
constexpr size_t WS_WO = 57 * MiB;
constexpr size_t WS_WGU = 65 * MiB;
constexpr size_t WS_WDN = 321 * MiB;
constexpr size_t WS_XCT = 65 * MiB;
constexpr size_t WS_BCC = 130 * MiB;
constexpr size_t WS_CCC = 147 * MiB;
constexpr size_t WS_BTT = 164 * MiB;
constexpr size_t WS_H0 = 449 * MiB;
constexpr size_t WS_T1S = 449 * MiB;
constexpr size_t WS_SST = 321 * MiB;
constexpr size_t WS_PREV = 960 * MiB;
constexpr size_t WS_ZP = 514 * MiB;
constexpr size_t WS_U = 514 * MiB;
constexpr size_t WS_H1 = 642 * MiB;
constexpr size_t WS_H1B = 770 * MiB;
constexpr size_t WS_LIST = 834 * MiB;
constexpr size_t WS_LISTW = 838 * MiB;
constexpr size_t WS_POS = 842 * MiB;
constexpr size_t WS_HID = 844 * MiB;
constexpr size_t WS_AY = 864 * MiB;
constexpr size_t WS_MERGED = 960 * MiB;
constexpr size_t WS_Y = 892 * MiB;
constexpr size_t WS_END = 1024 * MiB;

DEVINL float bf2f(bf16_t h) { return __uint_as_float(((unsigned)h) << 16); }
typedef __bf16 bf16x2_t __attribute__((ext_vector_type(2)));
typedef float f32x2_t __attribute__((ext_vector_type(2)));
DEVINL unsigned cvtpk(float lo, float hi) { f32x2_t v = {lo, hi}; bf16x2_t b = __builtin_convertvector(v, bf16x2_t); return __builtin_bit_cast(unsigned, b); }
DEVINL unsigned pk2(float lo, float hi) { return cvtpk(lo, hi); }
DEVINL bf16_t f2bf(float f) { return (bf16_t)(cvtpk(f, 0.f) & 0xffffu); }
DEVINL float bf_lo(unsigned w) { return __uint_as_float(w << 16); }
DEVINL float bf_hi(unsigned w) { return __uint_as_float(w & 0xffff0000u); }
DEVINL float wave_sum(float v) {
#pragma unroll
    for (int o = 1; o < 64; o <<= 1) v += __shfl_xor(v, o);
    return v;
}
DEVINL float sigmoidf(float x) { return __builtin_amdgcn_rcpf(1.f + __builtin_amdgcn_exp2f(-1.4426950408889634f * x)); }
DEVINL float siluf(float x) { return x * __builtin_amdgcn_rcpf(1.f + __builtin_amdgcn_exp2f(-1.4426950408889634f * x)); }
DEVINL int prow_of(int r) { return (r >> 13) * LP + 128 + (r & (SEQ - 1)); }
#define LDS_WAIT() asm volatile("s_waitcnt lgkmcnt(0)" ::: "memory")

namespace pg8 {
#define PG8_LAS __attribute__((address_space(3)))
typedef float f32x4 __attribute__((ext_vector_type(4)));
typedef unsigned u32x4 __attribute__((ext_vector_type(4)));
typedef unsigned u32x2 __attribute__((ext_vector_type(2)));
constexpr int BM = 256, BK = 64, HALF = 128, HTB = HALF * BK * 2, STAGE_BYTES = 8 * HTB, NXCD = 8, WGM = 8;
__host__ __device__ __forceinline__ int lds_byte(int r, int c) { const int st = (r >> 4) * 2 + (c >> 5), rr = r & 15, cc = c & 31, ob = rr * 64 + cc * 2; return st * 1024 + (ob ^ (((ob >> 9) & 1) << 5)); }
__host__ __device__ __forceinline__ void stage_rc(int b, int& R, int& C) { const int st = b / 1024, sb = b % 1024, swz = sb ^ (((sb >> 9) & 1) << 5); R = (st >> 1) * 16 + swz / 64; C = (st & 1) * 32 + (swz % 64) / 2; }
__host__ __device__ __forceinline__ int perm32(int rho) { const int n = rho >> 4, i = rho & 15; return 8 * (i >> 2) + 4 * n + (i & 3); }
struct Unit { int pm, pn; };
struct Gemm { const bf16_t* A; const bf16_t* Bt; int lda, ldb, K; };

struct StaticOrder {
    int nM, nN, nwg, G, c, wgm; const bf16_t* A; const bf16_t* Bt; int lda, ldb;
    __device__ void init(const Gemm& g, int M, int N, int G_, int c_, int wgm_ = WGM) { nM = M / BM; nN = N / BM; nwg = nM * nN; G = G_; c = c_; wgm = wgm_; A = g.A; Bt = g.Bt; lda = g.lda; ldb = g.ldb; }
    __device__ bool next(int i, Unit& u) const {
        const long L = (long)i * G + c; if (L >= nwg) return false;
        int wgid = (int)L; { const int q = nwg / NXCD, r = nwg % NXCD, xcd = wgid % NXCD, off = wgid / NXCD; wgid = (xcd < r ? xcd * (q + 1) : r * (q + 1) + (xcd - r) * q) + off; }
        const int nig = wgm * nN, gid = wgid / nig, fm = gid * wgm, gsz = (nM - fm) < wgm ? (nM - fm) : wgm;
        u.pm = fm + ((wgid % nig) % gsz); u.pn = (wgid % nig) / gsz; return true;
    }
    __device__ __forceinline__ const char* a_base(const Unit& u) const { return (const char*)(A + (size_t)u.pm * BM * lda); }
    __device__ __forceinline__ const char* b_base(const Unit& u) const { return (const char*)(Bt + (size_t)u.pn * BM * ldb); }
    __device__ __forceinline__ int a_row(const Unit&, int r) const { return r; }
    __device__ __forceinline__ bool half(const Unit&) const { return false; }
};
__device__ __forceinline__ unsigned cvt_pk_bf16(float lo, float hi) { unsigned r; asm volatile("v_cvt_pk_bf16_f32 %0, %1, %2" : "=v"(r) : "v"(lo), "v"(hi)); return r; }

template <class Epi, class Sched, bool ALIGN_EPI, bool GATHER, int MIDK = -1>
__device__ __forceinline__ void gemm_phase(PG8_LAS unsigned char* lds, const Gemm g, const Sched& S, const Epi& E) {
    const int tid = threadIdx.x, wid = __builtin_amdgcn_readfirstlane(tid >> 6), lane = tid & 63, wr = wid >> 2, wc = wid & 3, fr = lane & 15, fq = lane >> 4;
    const int K = g.K, nt = K / BK;
    unsigned voffA[2][2], voffB[2]; int RA[2], CA[2];
#pragma unroll
    for (int i = 0; i < 2; ++i) { int R, C; stage_rc(tid * 16 + i * 8192, R, C); const int Rb = Epi::PERM ? ((R & ~31) + perm32(R & 31)) : R;
        RA[i] = R; CA[i] = C; voffA[0][i] = (unsigned)(R * g.lda + C) * 2u; voffA[1][i] = (unsigned)((R + HALF) * g.lda + C) * 2u; voffB[i] = (unsigned)(Rb * g.ldb + C) * 2u; }
    const size_t kstep = (size_t)(BK * 2);
    const size_t hstepB = (size_t)HALF * g.ldb * 2;
    const unsigned ldsw = (unsigned)wid * 1024u;
    const int aoff = lds_byte(wr * 64 + fr, fq * 8), boff = lds_byte(wc * 32 + fr, fq * 8);
#define PG8_SA(b, h) (((b) * 2 + (h)) * HTB)
#define PG8_SB(b, h) ((4 + (b) * 2 + (h)) * HTB)
#define PG8_STAGE(bufoff, gbase, voff) do { _Pragma("unroll") for (int _i = 0; _i < 2; ++_i) \
        __builtin_amdgcn_global_load_lds((const unsigned*)((const char*)(gbase) + (voff)[_i]), (PG8_LAS unsigned*)(lds + (bufoff) + ldsw + _i * 8192), 16, 0, 0); } while (0)
#define PG8_LDA(dst, b, h) do { _Pragma("unroll") for (int m = 0; m < 4; ++m) _Pragma("unroll") for (int k = 0; k < 2; ++k) dst[m][k] = *(const PG8_LAS bf16x8*)(lds + PG8_SA(b, h) + aoff + m * 2048 + k * 1024); } while (0)
#define PG8_LDB(dst, b, h) do { _Pragma("unroll") for (int n = 0; n < 2; ++n) _Pragma("unroll") for (int k = 0; k < 2; ++k) dst[n][k] = *(const PG8_LAS bf16x8*)(lds + PG8_SB(b, h) + boff + n * 2048 + k * 1024); } while (0)
#define PG8_MMA(ai, bj, At, Bt) do { __builtin_amdgcn_s_setprio(1); _Pragma("unroll") for (int m = 0; m < 4; ++m) _Pragma("unroll") for (int n = 0; n < 2; ++n) _Pragma("unroll") for (int k = 0; k < 2; ++k) \
        acc[ai][bj][m][n] = __builtin_amdgcn_mfma_f32_16x16x32_bf16(Bt[n][k], At[m][k], acc[ai][bj][m][n], 0, 0, 0); __builtin_amdgcn_s_setprio(0); } while (0)
#define PG8_WAIT_V(n) asm volatile("s_waitcnt vmcnt(" #n ")" ::: "memory")
#define PG8_WAIT_L(n) asm volatile("s_waitcnt lgkmcnt(" #n ")" ::: "memory")
#define PG8_BAR __builtin_amdgcn_s_barrier()
#define PG8_SCHED __builtin_amdgcn_sched_barrier(0)
#define PG8_GVOFF(u, vo) do { if constexpr (GATHER) { _Pragma("unroll") for (int _h = 0; _h < 2; ++_h) _Pragma("unroll") for (int _i = 0; _i < 2; ++_i) \
        vo[_h][_i] = (unsigned)(S.a_row(u, _h * HALF + RA[_i]) * g.lda + CA[_i]) * 2u; } } while (0)
    Unit cur, nxt; int ui = 0;
    if (!S.next(0, cur)) return;
    f32x4 acc[2][2][4][2];
#pragma unroll
    for (int a = 0; a < 2; ++a)
#pragma unroll
        for (int b = 0; b < 2; ++b)
#pragma unroll
            for (int m = 0; m < 4; ++m)
#pragma unroll
                for (int n = 0; n < 2; ++n) acc[a][b][m][n] = (f32x4){0.f, 0.f, 0.f, 0.f};
    bf16x8 At[4][2], B0[2][2], B1[2][2];
    unsigned nvoffA[2][2];
    PG8_GVOFF(cur, voffA);
    const char* cA = S.a_base(cur); const char* cB = S.b_base(cur);
    PG8_STAGE(PG8_SB(0, 0), cB, voffB); PG8_STAGE(PG8_SB(0, 1), cB + hstepB, voffB); PG8_STAGE(PG8_SA(0, 0), cA, voffA[0]); PG8_STAGE(PG8_SA(0, 1), cA, voffA[1]);
    if (wr == 1) PG8_BAR;
    PG8_WAIT_V(2); PG8_BAR;
    PG8_STAGE(PG8_SB(1, 0), cB + kstep, voffB); PG8_STAGE(PG8_SA(1, 0), cA + kstep, voffA[0]); PG8_STAGE(PG8_SB(1, 1), cB + hstepB + kstep, voffB);
    PG8_WAIT_V(6); PG8_BAR;
    for (;;) {
        const bool has_next = S.next(ui + 1, nxt);
        const bool hf = S.half(cur);
        const char* nA = has_next ? S.a_base(nxt) : cA; const char* nB = has_next ? S.b_base(nxt) : cB;
        if constexpr (GATHER) { if (has_next) { PG8_GVOFF(nxt, nvoffA); } else {
#pragma unroll
            for (int _h = 0; _h < 2; ++_h)
#pragma unroll
                for (int _i = 0; _i < 2; ++_i) nvoffA[_h][_i] = voffA[_h][_i]; } }
        for (int t = 0; t < nt; t += 2) {
            if constexpr (MIDK > 0) { if (t == MIDK) E.mid(acc, cur, wr, wc, fr, fq); }
            const bool last = (t == nt - 2);
            const char* a1 = cA + (size_t)(t + 1) * kstep;
            const char* a2 = last ? nA : cA + (size_t)(t + 2) * kstep; const char* b2 = last ? nB : cB + (size_t)(t + 2) * kstep;
            const char* a3 = a2 + kstep; const char* b3 = b2 + kstep;
            unsigned va0[2], va1[2];
            if constexpr (GATHER) { va0[0] = last ? nvoffA[0][0] : voffA[0][0]; va0[1] = last ? nvoffA[0][1] : voffA[0][1]; va1[0] = last ? nvoffA[1][0] : voffA[1][0]; va1[1] = last ? nvoffA[1][1] : voffA[1][1]; }
            else { va0[0] = voffA[0][0]; va0[1] = voffA[0][1]; va1[0] = voffA[1][0]; va1[1] = voffA[1][1]; }
            PG8_LDB(B0, 0, 0); PG8_LDB(B1, 0, 1); PG8_SCHED; PG8_LDA(At, 0, 0); PG8_STAGE(PG8_SA(1, 1), a1, voffA[1]);
            PG8_WAIT_V(8); PG8_WAIT_L(0); PG8_BAR; PG8_MMA(0, 0, At, B0); PG8_MMA(0, 1, At, B1); PG8_BAR; PG8_SCHED;
            PG8_LDA(At, 0, 1); PG8_STAGE(PG8_SB(0, 0), b2, voffB); PG8_STAGE(PG8_SB(0, 1), b2 + hstepB, voffB); PG8_STAGE(PG8_SA(0, 0), a2, va0);
            PG8_WAIT_V(8); PG8_WAIT_L(0); PG8_BAR; if (!hf) { PG8_MMA(1, 0, At, B0); PG8_MMA(1, 1, At, B1); } PG8_BAR; PG8_SCHED;
            PG8_LDB(B0, 1, 0); PG8_LDB(B1, 1, 1); PG8_SCHED; PG8_LDA(At, 1, 0); PG8_STAGE(PG8_SA(0, 1), a2, va1);
            PG8_WAIT_V(8); PG8_WAIT_L(0); PG8_BAR; PG8_MMA(0, 0, At, B0); PG8_MMA(0, 1, At, B1); PG8_BAR; PG8_SCHED;
            PG8_LDA(At, 1, 1); PG8_STAGE(PG8_SB(1, 0), b3, voffB); PG8_STAGE(PG8_SB(1, 1), b3 + hstepB, voffB); PG8_STAGE(PG8_SA(1, 0), a3, va0);
            PG8_WAIT_V(8); PG8_WAIT_L(0); PG8_BAR; if (!hf) { PG8_MMA(1, 0, At, B0); PG8_MMA(1, 1, At, B1); } PG8_BAR; PG8_SCHED;
        }
        if constexpr (ALIGN_EPI) { if (wr == 0) PG8_BAR; }
        E(acc, cur, wr, wc, fr, fq);
        if (!has_next) break;
#pragma unroll
        for (int a = 0; a < 2; ++a)
#pragma unroll
            for (int b = 0; b < 2; ++b)
#pragma unroll
                for (int m = 0; m < 4; ++m)
#pragma unroll
                    for (int n = 0; n < 2; ++n) acc[a][b][m][n] = (f32x4){0.f, 0.f, 0.f, 0.f};
        cur = nxt; cA = nA; cB = nB; ++ui;
        if constexpr (GATHER) {
#pragma unroll
            for (int _h = 0; _h < 2; ++_h)
#pragma unroll
                for (int _i = 0; _i < 2; ++_i) voffA[_h][_i] = nvoffA[_h][_i]; }
        if constexpr (ALIGN_EPI) { if (wr == 1) PG8_BAR; }
    }
    PG8_WAIT_V(0);
    if constexpr (!ALIGN_EPI) { if (wr == 0) PG8_BAR; }
    PG8_BAR;
#undef PG8_SA
#undef PG8_SB
#undef PG8_STAGE
#undef PG8_LDA
#undef PG8_LDB
#undef PG8_MMA
#undef PG8_WAIT_V
#undef PG8_WAIT_L
#undef PG8_BAR
#undef PG8_SCHED
#undef PG8_GVOFF
}
#define PG8_GAS __attribute__((address_space(1)))
typedef const PG8_GAS char* gptr;
__device__ __forceinline__ gptr uniform_ptr(const char* p) { const unsigned long long v = (unsigned long long)p; const unsigned lo = __builtin_amdgcn_readfirstlane((unsigned)v), hi = __builtin_amdgcn_readfirstlane((unsigned)(v >> 32)); return (gptr)(((unsigned long long)hi << 32) | lo); }
struct WF32 { const float* W0; const float* W1; size_t estride; int pn_step; int ldw; };
typedef float f32x2 __attribute__((ext_vector_type(2)));
template <class Epi, class Sched, bool GATHER, int ROWMAP, bool SP2S = false, int FLOW = 0>
__device__ __forceinline__ void gemm_phase_wf32(PG8_LAS unsigned char* lds, const Gemm g, const Sched& S, const Epi& E, const WF32 wf) {
    static_assert(Epi::PERM, "the B staging map below is the PERM one");
    const int tid = threadIdx.x, wid = __builtin_amdgcn_readfirstlane(tid >> 6), lane = tid & 63, wr = wid >> 2, wc = wid & 3, fr = lane & 15, fq = lane >> 4;
    const int K = g.K, nt = K / BK;
    unsigned voffA[2][2]; int RA[2], CA[2];
#pragma unroll
    for (int i = 0; i < 2; ++i) { int R, C; stage_rc(tid * 16 + i * 8192, R, C); RA[i] = R; CA[i] = C; voffA[0][i] = (unsigned)(R * g.lda + C) * 2u; voffA[1][i] = (unsigned)((R + HALF) * g.lda + C) * 2u; }
    const size_t kstep = (size_t)(BK * 2), hstepA = (size_t)HALF * g.lda * 2;
    const unsigned ldsw = (unsigned)wid * 1024u, ldsb = (unsigned)(size_t)lds;
    const int aoff = lds_byte(wr * 64 + fr, fq * 8);
    const int bn_o = 2 * ((wid & 3) * 16 + (lane >> 2)), bc_o = bn_o & 31, bR_o = (bn_o & ~31) + 16 * ((bc_o >> 2) & 1) + 4 * (bc_o >> 3) + (bc_o & 3), bk_o = 32 * (wid >> 2) + 8 * (lane & 3);
    const int bn2 = 2 * lane, bc2 = bn2 & 31, bR2 = (bn2 & ~31) + 16 * ((bc2 >> 2) & 1) + 4 * (bc2 >> 3) + (bc2 & 3);
    const int bR = (ROWMAP == 1 || ROWMAP == 3 || ROWMAP == 5 || ROWMAP == 6) ? 2 * lane : ROWMAP == 2 ? bR2 : bR_o, bn = (ROWMAP == 1 || ROWMAP == 3 || ROWMAP == 5 || ROWMAP == 6) ? (bR & ~31) + perm32(bR & 31) : ROWMAP == 2 ? bn2 : bn_o;
    const unsigned vbo = (unsigned)((ROWMAP ? 8 * wid : bk_o) * wf.ldw + bn) * 4u;
    const int wb0 = (ROWMAP == 1 || ROWMAP == 5) ? bR * 128 + ((wid ^ (lane & 7)) << 4) : ROWMAP == 0 ? lds_byte(bR_o, bk_o) : lds_byte(bR, 8 * wid), wb1 = (ROWMAP == 1 || ROWMAP == 5) ? wb0 + 128 : ROWMAP == 0 ? lds_byte(bR_o + 1, bk_o) : lds_byte(bR + 1, 8 * wid);
    const int boff0 = (ROWMAP == 1 || ROWMAP == 6 || ROWMAP == 7) ? (wc * 32 + fr) * 128 + ((fq ^ (fr >> 1)) << 4) : lds_byte(wc * 32 + fr, fq * 8), boff1 = (ROWMAP == 1 || ROWMAP == 6 || ROWMAP == 7) ? (wc * 32 + fr) * 128 + (((fq + 4) ^ (fr >> 1)) << 4) : boff0 + 1024;
    const size_t ldwb = (size_t)wf.ldw * 4, kstepB = (size_t)BK * ldwb;
    const int c4 = 4 * (lane & 31), r4 = (c4 & ~31) + 16 * ((c4 >> 2) & 1) + 4 * ((c4 & 31) >> 3), s4 = (r4 >> 1) & 7;
    const unsigned vbo7 = (unsigned)((8 * wid + 4 * (lane >> 5)) * wf.ldw + c4) * 4u;
    const int wq0 = r4 * 128 + ((wid ^ s4) << 4) + 8 * (lane >> 5); const int wq2d = 256 + ((wid & 1) ? -16 : 16);
#define wq2 (wq0 + wq2d)
#define PG8_SA(b, h) (((b) * 2 + (h)) * HTB)
#define PG8_SB(b, h) ((4 + (b) * 2 + (h)) * HTB)
#define PG8_STAGE(bufoff, gbase, voff) do { _Pragma("unroll") for (int _i = 0; _i < 2; ++_i) \
        { gptr _t; asm volatile("s_mov_b32 m0, %1\n\ts_mov_b64 %0, %3\n\tglobal_load_lds_dwordx4 %2, %0" : "=&s"(_t) : "s"(ldsb + (unsigned)(bufoff) + ldsw + _i * 8192u), "v"((voff)[_i]), "s"((gptr)(gbase)) : "memory"); } } while (0)
#define PG8_STAGE1(bufoff, gbase, vo1, vo0) do { if constexpr (GATHER) { PG8_STAGE(bufoff, gbase, vo1); } else { PG8_STAGE(bufoff, (gbase) + hstepA, vo0); } } while (0)
#define PG8_LDAH(dst, b, h, mh) do { _Pragma("unroll") for (int m = 0; m < 2; ++m) _Pragma("unroll") for (int k = 0; k < 2; ++k) dst[m][k] = *(const PG8_LAS bf16x8*)(lds + PG8_SA(b, h) + aoff + (2 * (mh) + m) * 2048 + k * 1024); } while (0)
#define PG8_LDB(dst, b, h) do { _Pragma("unroll") for (int n = 0; n < 2; ++n) { dst[n][0] = *(const PG8_LAS bf16x8*)(lds + PG8_SB(b, h) + boff0 + n * 2048); dst[n][1] = *(const PG8_LAS bf16x8*)(lds + PG8_SB(b, h) + boff1 + n * 2048); } } while (0)
#define PG8_MMAH(ai, mh) do { __builtin_amdgcn_s_setprio(1); _Pragma("unroll") for (int m = 0; m < 2; ++m) _Pragma("unroll") for (int n = 0; n < 2; ++n) _Pragma("unroll") for (int k = 0; k < 2; ++k) { \
        acc[ai][0][2 * (mh) + m][n] = __builtin_amdgcn_mfma_f32_16x16x32_bf16(B0[n][k], Ah[m][k], acc[ai][0][2 * (mh) + m][n], 0, 0, 0); \
        acc[ai][1][2 * (mh) + m][n] = __builtin_amdgcn_mfma_f32_16x16x32_bf16(B1[n][k], Ah[m][k], acc[ai][1][2 * (mh) + m][n], 0, 0, 0); } __builtin_amdgcn_s_setprio(0); } while (0)
#define PG8_BLOAD(X, src) do { if constexpr (ROWMAP == 7) { _Pragma("unroll") for (int _j = 0; _j < 4; ++_j) { const gptr _sj = (gptr)(src) + (size_t)_j * ldwb; gptr _t; asm volatile("s_mov_b64 %1, %3\n\tglobal_load_dwordx4 %0, %2, %1" : "=&v"(X##4[_j]), "=&s"(_t) : "v"(vbo7), "s"(_sj) : "memory"); } break; } _Pragma("unroll") for (int _j = 0; _j < 8; ++_j) { const gptr _sj = (gptr)(src) + (size_t)_j * ldwb; gptr _t; asm volatile("s_mov_b64 %1, %3\n\tglobal_load_dwordx2 %0, %2, %1" : "=&v"(X[_j]), "=&s"(_t) : "v"(vbo), "s"(_sj) : "memory"); } } while (0)
#define PG8_BWRITE(X, bufoff) do { if constexpr (ROWMAP == 7) { u32x2 _c0, _c1, _c2, _c3; \
        _c0.x = cvt_pk_bf16(X##4[0][0], X##4[1][0]); _c0.y = cvt_pk_bf16(X##4[2][0], X##4[3][0]); _c1.x = cvt_pk_bf16(X##4[0][1], X##4[1][1]); _c1.y = cvt_pk_bf16(X##4[2][1], X##4[3][1]); \
        _c2.x = cvt_pk_bf16(X##4[0][2], X##4[1][2]); _c2.y = cvt_pk_bf16(X##4[2][2], X##4[3][2]); _c3.x = cvt_pk_bf16(X##4[0][3], X##4[1][3]); _c3.y = cvt_pk_bf16(X##4[2][3], X##4[3][3]); \
        *(PG8_LAS u32x2*)(lds + (bufoff) + wq0) = _c0; *(PG8_LAS u32x2*)(lds + (bufoff) + wq0 + 128) = _c1; *(PG8_LAS u32x2*)(lds + (bufoff) + wq2) = _c2; *(PG8_LAS u32x2*)(lds + (bufoff) + wq2 + 128) = _c3; break; } u32x4 _w0, _w1; \
        _w0.x = cvt_pk_bf16(X[0].x, X[1].x); _w0.y = cvt_pk_bf16(X[2].x, X[3].x); _w0.z = cvt_pk_bf16(X[4].x, X[5].x); _w0.w = cvt_pk_bf16(X[6].x, X[7].x); \
        _w1.x = cvt_pk_bf16(X[0].y, X[1].y); _w1.y = cvt_pk_bf16(X[2].y, X[3].y); _w1.z = cvt_pk_bf16(X[4].y, X[5].y); _w1.w = cvt_pk_bf16(X[6].y, X[7].y); \
        *(PG8_LAS u32x4*)(lds + (bufoff) + wb0) = _w0; *(PG8_LAS u32x4*)(lds + (bufoff) + wb1) = _w1; } while (0)
#define PG8_WAIT_V(n) do { if constexpr (ROWMAP == 7 && (n) == 12) asm volatile("s_waitcnt vmcnt(8)" ::: "memory"); else if constexpr (ROWMAP == 7 && (n) == 10) asm volatile("s_waitcnt vmcnt(6)" ::: "memory"); \
        else if constexpr (ROWMAP == 7 && (n) == 8) asm volatile("s_waitcnt vmcnt(4)" ::: "memory"); else asm volatile("s_waitcnt vmcnt(" #n ")" ::: "memory"); } while (0)
#define PG8_WAIT_VR(n) asm volatile("s_waitcnt vmcnt(" #n ")" ::: "memory")
#define PG8_LDAF(dst, b, h) do { _Pragma("unroll") for (int m = 0; m < 4; ++m) _Pragma("unroll") for (int k = 0; k < 2; ++k) dst[m][k] = *(const PG8_LAS bf16x8*)(lds + PG8_SA(b, h) + aoff + m * 2048 + k * 1024); } while (0)
#define PG8_MMAF(ai, bj, At, Bt) do { __builtin_amdgcn_s_setprio(1); _Pragma("unroll") for (int m = 0; m < 4; ++m) _Pragma("unroll") for (int n = 0; n < 2; ++n) _Pragma("unroll") for (int k = 0; k < 2; ++k) \
        acc[ai][bj][m][n] = __builtin_amdgcn_mfma_f32_16x16x32_bf16(Bt[n][k], At[m][k], acc[ai][bj][m][n], 0, 0, 0); __builtin_amdgcn_s_setprio(0); } while (0)
#define PG8_WAIT_L(n) asm volatile("s_waitcnt lgkmcnt(" #n ")" ::: "memory")
#define PG8_BAR __builtin_amdgcn_s_barrier()
#define PG8_SCHED __builtin_amdgcn_sched_barrier(0)
#define PG8_GVOFF(u, vo) do { if constexpr (GATHER) { _Pragma("unroll") for (int _h = 0; _h < 2; ++_h) _Pragma("unroll") for (int _i = 0; _i < 2; ++_i) \
        vo[_h][_i] = (unsigned)(S.a_row(u, _h * HALF + RA[_i]) * g.lda + CA[_i]) * 2u; } } while (0)
    Unit cur, nxt; int ui = 0;
    if (!S.next(0, cur)) return;
    f32x4 acc[2][2][4][2];
#pragma unroll
    for (int a = 0; a < 2; ++a)
#pragma unroll
        for (int b = 0; b < 2; ++b)
#pragma unroll
            for (int m = 0; m < 4; ++m)
#pragma unroll
                for (int n = 0; n < 2; ++n) acc[a][b][m][n] = (f32x4){0.f, 0.f, 0.f, 0.f};
    bf16x8 Ah[2][2], B0[2][2], B1[2][2]; bf16x8 At[4][2];
    f32x2 X[8], Y[8]; f32x4 X4[4], Y4[4];
    unsigned nvoffA[2][2];
    PG8_GVOFF(cur, voffA);
    gptr cA = uniform_ptr(S.a_base(cur)); gptr cB0 = uniform_ptr(S.w_base(cur, wf, 0)); gptr cB1 = uniform_ptr(S.w_base(cur, wf, 1));
    PG8_BLOAD(X, cB0); PG8_BLOAD(Y, cB1);
    PG8_STAGE(PG8_SA(0, 0), cA, voffA[0]); PG8_STAGE1(PG8_SA(0, 1), cA, voffA[1], voffA[0]);
    PG8_WAIT_V(12); PG8_BWRITE(X, PG8_SB(0, 0)); PG8_BLOAD(X, cB0 + kstepB);
    PG8_WAIT_V(12); PG8_BWRITE(Y, PG8_SB(0, 1)); PG8_BLOAD(Y, cB1 + kstepB);
    PG8_WAIT_V(8); PG8_BWRITE(X, PG8_SB(1, 0)); PG8_BLOAD(X, cB0 + 2 * kstepB);
    PG8_STAGE(PG8_SA(1, 0), cA + kstep, voffA[0]);
    PG8_WAIT_V(10); PG8_BWRITE(Y, PG8_SB(1, 1)); PG8_BLOAD(Y, cB1 + 2 * kstepB);
    if constexpr (SP2S) { static_assert(!SP2S || ROWMAP == 7, "SP2S counts assume 4 loads per site"); PG8_WAIT_VR(0); }
    PG8_WAIT_L(0);
    if (wr == 1) PG8_BAR;
    PG8_BAR;
    for (;;) {
        const bool has_next = S.next(ui + 1, nxt);
        const bool hf = S.half(cur);
        const gptr nA = has_next ? uniform_ptr(S.a_base(nxt)) : cA;
        const gptr nB0 = has_next ? uniform_ptr(S.w_base(nxt, wf, 0)) : cB0; const gptr nB1 = has_next ? uniform_ptr(S.w_base(nxt, wf, 1)) : cB1;
        if constexpr (GATHER) { if (has_next) { PG8_GVOFF(nxt, nvoffA); } else {
#pragma unroll
            for (int _h = 0; _h < 2; ++_h)
#pragma unroll
                for (int _i = 0; _i < 2; ++_i) nvoffA[_h][_i] = voffA[_h][_i]; } }
        for (int t = 0; t < nt; t += 2) {
            const bool last = (t == nt - 2);
            const gptr a1 = cA + (size_t)(t + 1) * kstep;
            const gptr a2 = last ? nA : cA + (size_t)(t + 2) * kstep; const gptr a3 = a2 + kstep;
            unsigned va0[2], va1[2];
            if constexpr (GATHER) { va0[0] = last ? nvoffA[0][0] : voffA[0][0]; va0[1] = last ? nvoffA[0][1] : voffA[0][1]; va1[0] = last ? nvoffA[1][0] : voffA[1][0]; va1[1] = last ? nvoffA[1][1] : voffA[1][1]; }
            else { va0[0] = voffA[0][0]; va0[1] = voffA[0][1]; va1[0] = voffA[1][0]; va1[1] = voffA[1][1]; }
            const size_t o3 = (t + 3 < nt) ? (size_t)(t + 3) * kstepB : (size_t)(t + 3 - nt) * kstepB, o4 = (t + 4 < nt) ? (size_t)(t + 4) * kstepB : (size_t)(t + 4 - nt) * kstepB;
            const gptr x3 = ((t + 3 < nt) ? cB0 : nB0) + o3; const gptr y3 = ((t + 3 < nt) ? cB1 : nB1) + o3;
            const gptr x4 = ((t + 4 < nt) ? cB0 : nB0) + o4; const gptr y4 = ((t + 4 < nt) ? cB1 : nB1) + o4;
            if constexpr (SP2S) {
            PG8_LDB(B0, 0, 0); PG8_LDB(B1, 0, 1); PG8_SCHED; PG8_LDAF(At, 0, 0); PG8_STAGE1(PG8_SA(1, 1), a1, voffA[1], voffA[0]);
            PG8_WAIT_VR(12); PG8_WAIT_L(8); PG8_BAR; PG8_WAIT_L(0); PG8_MMAF(0, 0, At, B0); PG8_MMAF(0, 1, At, B1); PG8_BAR; PG8_SCHED;
            PG8_LDAF(At, 0, 1); PG8_WAIT_VR(8); PG8_BWRITE(X, PG8_SB(0, 0)); PG8_BLOAD(X, x3); PG8_WAIT_VR(8); PG8_BWRITE(Y, PG8_SB(0, 1)); PG8_BLOAD(Y, y3); PG8_STAGE(PG8_SA(0, 0), a2, va0);
            PG8_WAIT_VR(12); PG8_BAR; PG8_WAIT_L(0); if (!hf) { PG8_MMAF(1, 0, At, B0); PG8_MMAF(1, 1, At, B1); } PG8_BAR; PG8_SCHED;
            PG8_LDB(B0, 1, 0); PG8_LDB(B1, 1, 1); PG8_SCHED; PG8_LDAF(At, 1, 0); PG8_STAGE1(PG8_SA(0, 1), a2, va1, va0);
            PG8_WAIT_VR(12); PG8_WAIT_L(8); PG8_BAR; PG8_WAIT_L(0); PG8_MMAF(0, 0, At, B0); PG8_MMAF(0, 1, At, B1); PG8_BAR; PG8_SCHED;
            PG8_LDAF(At, 1, 1); PG8_WAIT_VR(8); PG8_BWRITE(X, PG8_SB(1, 0)); PG8_BLOAD(X, x4); PG8_WAIT_VR(8); PG8_BWRITE(Y, PG8_SB(1, 1)); PG8_BLOAD(Y, y4); PG8_STAGE(PG8_SA(1, 0), a3, va0);
            PG8_WAIT_VR(12); PG8_BAR; PG8_WAIT_L(0); if (!hf) { PG8_MMAF(1, 0, At, B0); PG8_MMAF(1, 1, At, B1); } PG8_BAR; PG8_SCHED;
            } else {
            PG8_LDB(B0, 0, 0); PG8_LDB(B1, 0, 1); PG8_SCHED; PG8_LDAH(Ah, 0, 0, 0); PG8_STAGE1(PG8_SA(1, 1), a1, voffA[1], voffA[0]);
            PG8_WAIT_L(4); PG8_BAR; PG8_WAIT_L(0); PG8_MMAH(0, 0); PG8_BAR; PG8_SCHED;
            PG8_LDAH(Ah, 0, 0, 1); PG8_WAIT_V(12); PG8_BWRITE(X, PG8_SB(0, 0)); PG8_BLOAD(X, x3);
            PG8_BAR; PG8_WAIT_L(0); PG8_MMAH(0, 1); PG8_BAR; PG8_SCHED;
            PG8_LDAH(Ah, 0, 1, 0); PG8_STAGE(PG8_SA(0, 0), a2, va0);
            PG8_BAR; PG8_WAIT_L(0); if (!hf) { PG8_MMAH(1, 0); } PG8_BAR; PG8_SCHED;
            PG8_LDAH(Ah, 0, 1, 1); PG8_WAIT_V(10); PG8_BWRITE(Y, PG8_SB(0, 1)); PG8_BLOAD(Y, y3);
            PG8_BAR; PG8_WAIT_L(0); if (!hf) { PG8_MMAH(1, 1); } PG8_BAR; PG8_SCHED;
            PG8_LDB(B0, 1, 0); PG8_LDB(B1, 1, 1); PG8_SCHED; PG8_LDAH(Ah, 1, 0, 0); PG8_STAGE1(PG8_SA(0, 1), a2, va1, va0);
            PG8_WAIT_L(4); PG8_BAR; PG8_WAIT_L(0); PG8_MMAH(0, 0); PG8_BAR; PG8_SCHED;
            PG8_LDAH(Ah, 1, 0, 1); PG8_WAIT_V(12); PG8_BWRITE(X, PG8_SB(1, 0)); PG8_BLOAD(X, x4);
            PG8_BAR; PG8_WAIT_L(0); PG8_MMAH(0, 1); PG8_BAR; PG8_SCHED;
            PG8_LDAH(Ah, 1, 1, 0); PG8_STAGE(PG8_SA(1, 0), a3, va0);
            PG8_BAR; PG8_WAIT_L(0); if (!hf) { PG8_MMAH(1, 0); } PG8_BAR; PG8_SCHED;
            PG8_LDAH(Ah, 1, 1, 1); PG8_WAIT_V(10); PG8_BWRITE(Y, PG8_SB(1, 1)); PG8_BLOAD(Y, y4);
            PG8_BAR; PG8_WAIT_L(0); if (!hf) { PG8_MMAH(1, 1); } PG8_BAR; PG8_SCHED;
            }
        }
        if (wr == 0) PG8_BAR;
        E(acc, cur, wr, wc, fr, fq);
        if constexpr (FLOW == 1) {
            if (ui == S.arr_ui) {
                asm volatile("s_waitcnt vmcnt(0)" ::: "memory"); PG8_BAR;
                if (tid == 0) { __builtin_amdgcn_fence(__ATOMIC_RELEASE, "agent"); (void)__hip_atomic_fetch_add(S.arr, 1u, __ATOMIC_RELAXED, __HIP_MEMORY_SCOPE_AGENT); }
            }
        }
        if (!has_next) break;
#pragma unroll
        for (int a = 0; a < 2; ++a)
#pragma unroll
            for (int b = 0; b < 2; ++b)
#pragma unroll
                for (int m = 0; m < 4; ++m)
#pragma unroll
                    for (int n = 0; n < 2; ++n) acc[a][b][m][n] = (f32x4){0.f, 0.f, 0.f, 0.f};
        cur = nxt; cA = nA; cB0 = nB0; cB1 = nB1; ++ui;
        if constexpr (GATHER) {
#pragma unroll
            for (int _h = 0; _h < 2; ++_h)
#pragma unroll
                for (int _i = 0; _i < 2; ++_i) voffA[_h][_i] = nvoffA[_h][_i]; }
        if (wr == 1) PG8_BAR;
    }
    PG8_WAIT_V(0);
    PG8_BAR;
#undef PG8_SA
#undef PG8_SB
#undef PG8_STAGE
#undef PG8_LDAH
#undef PG8_LDB
#undef PG8_MMAH
#undef PG8_BLOAD
#undef PG8_BWRITE
#undef PG8_WAIT_V
#undef PG8_WAIT_L
#undef PG8_WAIT_VR
#undef PG8_STAGE1
#undef wq2
#undef PG8_LDAF
#undef PG8_MMAF
#undef PG8_BAR
#undef PG8_SCHED
#undef PG8_GVOFF
}
struct EpiBf16Plain {
    static constexpr bool PERM = true;
    bf16_t* O; size_t ldc;
    __device__ __forceinline__ void operator()(const f32x4 (&acc)[2][2][4][2], const Unit& u, int wr, int wc, int fr, int fq) const {
        const int row0 = u.pm * BM + wr * 64 + fr, col0 = u.pn * BM + wc * 32 + 8 * fq;
#pragma unroll
        for (int ai = 0; ai < 2; ++ai)
#pragma unroll
            for (int m = 0; m < 4; ++m) { bf16_t* rowp = O + (size_t)(row0 + ai * HALF + m * 16) * ldc + col0;
#pragma unroll
                for (int bj = 0; bj < 2; ++bj) { const f32x4 v0 = acc[ai][bj][m][0], v1 = acc[ai][bj][m][1];
                    u32x4 w; w.x = cvt_pk_bf16(v0[0], v0[1]); w.y = cvt_pk_bf16(v0[2], v0[3]); w.z = cvt_pk_bf16(v1[0], v1[1]); w.w = cvt_pk_bf16(v1[2], v1[3]);
                    __builtin_nontemporal_store(w, (u32x4*)(rowp + bj * HALF)); } }
    }
};

struct EpiBrA {
    static constexpr bool PERM = true;
    bf16_t* T1S; const bf16_t* ZP;
    __device__ __forceinline__ void operator()(const f32x4 (&acc)[2][2][4][2], const Unit& u, int wr, int wc, int fr, int fq) const {
        const int row0 = u.pm * BM + wr * 64 + fr, col0 = u.pn * BM + wc * 32 + 8 * fq;
        u32x4 gq[2][4][2];
#pragma unroll
        for (int ai = 0; ai < 2; ++ai)
#pragma unroll
            for (int m = 0; m < 4; ++m) { const size_t pr = (size_t)prow_of(row0 + ai * HALF + m * 16) * NIN + C_GA;
#pragma unroll
                for (int bj = 0; bj < 2; ++bj) gq[ai][m][bj] = *(const u32x4*)(ZP + pr + col0 + bj * HALF); }
        __builtin_amdgcn_sched_barrier(0);
#pragma unroll
        for (int ai = 0; ai < 2; ++ai)
#pragma unroll
            for (int m = 0; m < 4; ++m) { const int row = row0 + ai * HALF + m * 16;
#pragma unroll
                for (int bj = 0; bj < 2; ++bj) { const int col = col0 + bj * HALF; const u32x4 gw = gq[ai][m][bj];
                    const f32x4 v0 = acc[ai][bj][m][0], v1 = acc[ai][bj][m][1]; u32x4 w;
                    w.x = cvt_pk_bf16(sigmoidf(bf_lo(gw.x)) * v0[0], sigmoidf(bf_hi(gw.x)) * v0[1]); w.y = cvt_pk_bf16(sigmoidf(bf_lo(gw.y)) * v0[2], sigmoidf(bf_hi(gw.y)) * v0[3]);
                    w.z = cvt_pk_bf16(sigmoidf(bf_lo(gw.z)) * v1[0], sigmoidf(bf_hi(gw.z)) * v1[1]); w.w = cvt_pk_bf16(sigmoidf(bf_lo(gw.w)) * v1[2], sigmoidf(bf_hi(gw.w)) * v1[3]);
                    *(u32x4*)(T1S + (size_t)row * DM + col) = w; } }
    }
};
struct EpiBrS {
    static constexpr bool PERM = true;
    const bf16_t* T1S; const bf16_t* ZP; bf16_t* MG;
    __device__ __forceinline__ void operator()(const f32x4 (&acc)[2][2][4][2], const Unit& u, int wr, int wc, int fr, int fq) const {
        const int row0 = u.pm * BM + wr * 64 + fr, col0 = u.pn * BM + wc * 32 + 8 * fq;
#pragma unroll
        for (int ai = 0; ai < 2; ++ai) {
            u32x4 gq[4][2], tq[4][2];
#pragma unroll
            for (int m = 0; m < 4; ++m) { const int row = row0 + ai * HALF + m * 16; const size_t pr = (size_t)prow_of(row) * NIN + C_GS;
#pragma unroll
                for (int bj = 0; bj < 2; ++bj) { gq[m][bj] = *(const u32x4*)(ZP + pr + col0 + bj * HALF); tq[m][bj] = *(const u32x4*)(T1S + (size_t)row * DM + col0 + bj * HALF); } }
            __builtin_amdgcn_sched_barrier(0);
#pragma unroll
            for (int m = 0; m < 4; ++m) { const int row = row0 + ai * HALF + m * 16;
#pragma unroll
                for (int bj = 0; bj < 2; ++bj) { const int col = col0 + bj * HALF; const u32x4 gw = gq[m][bj], tw = tq[m][bj];
                    const f32x4 v0 = acc[ai][bj][m][0], v1 = acc[ai][bj][m][1]; u32x4 w;
                    w.x = cvt_pk_bf16(bf_lo(tw.x) + sigmoidf(bf_lo(gw.x)) * v0[0], bf_hi(tw.x) + sigmoidf(bf_hi(gw.x)) * v0[1]);
                    w.y = cvt_pk_bf16(bf_lo(tw.y) + sigmoidf(bf_lo(gw.y)) * v0[2], bf_hi(tw.y) + sigmoidf(bf_hi(gw.y)) * v0[3]);
                    w.z = cvt_pk_bf16(bf_lo(tw.z) + sigmoidf(bf_lo(gw.z)) * v1[0], bf_hi(tw.z) + sigmoidf(bf_hi(gw.z)) * v1[1]);
                    w.w = cvt_pk_bf16(bf_lo(tw.w) + sigmoidf(bf_lo(gw.w)) * v1[2], bf_hi(tw.w) + sigmoidf(bf_hi(gw.w)) * v1[3]);
                    *(u32x4*)(MG + (size_t)row * DM + col) = w; } }
            __builtin_amdgcn_sched_barrier(0);
        }
    }
};
struct EpiBrFused {
    static constexpr bool PERM = true;
    const bf16_t* ZP; bf16_t* MG;
    static __device__ __forceinline__ float ratio(float ga, float gs) { return (1.f + __builtin_amdgcn_exp2f(-1.4426950408889634f * gs)) * __builtin_amdgcn_rcpf(1.f + __builtin_amdgcn_exp2f(-1.4426950408889634f * ga)); }
    __device__ __forceinline__ void mid(f32x4 (&acc)[2][2][4][2], const Unit& u, int wr, int wc, int fr, int fq) const {
        const bf16_t* ZP = this->ZP; asm volatile("" : "+s"(ZP));
        const int row0 = u.pm * BM + wr * 64 + fr, col0 = u.pn * BM + wc * 32 + 8 * fq;
#pragma unroll
        for (int ai = 0; ai < 2; ++ai)
#pragma unroll
            for (int mp = 0; mp < 2; ++mp) {
                u32x4 ga[2][2], gs[2][2];
#pragma unroll
                for (int mm = 0; mm < 2; ++mm) { const size_t pr = (size_t)prow_of(row0 + ai * HALF + (2 * mp + mm) * 16) * NIN;
#pragma unroll
                    for (int bj = 0; bj < 2; ++bj) { ga[mm][bj] = *(const u32x4*)(ZP + pr + C_GA + col0 + bj * HALF); gs[mm][bj] = *(const u32x4*)(ZP + pr + C_GS + col0 + bj * HALF); } }
                __builtin_amdgcn_sched_barrier(0);
#pragma unroll
                for (int mm = 0; mm < 2; ++mm)
#pragma unroll
                    for (int bj = 0; bj < 2; ++bj) { f32x4& v0 = acc[ai][bj][2 * mp + mm][0]; f32x4& v1 = acc[ai][bj][2 * mp + mm][1]; const u32x4 a = ga[mm][bj], c = gs[mm][bj];
                        v0[0] *= ratio(bf_lo(a.x), bf_lo(c.x)); v0[1] *= ratio(bf_hi(a.x), bf_hi(c.x)); v0[2] *= ratio(bf_lo(a.y), bf_lo(c.y)); v0[3] *= ratio(bf_hi(a.y), bf_hi(c.y));
                        v1[0] *= ratio(bf_lo(a.z), bf_lo(c.z)); v1[1] *= ratio(bf_hi(a.z), bf_hi(c.z)); v1[2] *= ratio(bf_lo(a.w), bf_lo(c.w)); v1[3] *= ratio(bf_hi(a.w), bf_hi(c.w)); }
                __builtin_amdgcn_sched_barrier(0);
            }
    }
    __device__ __forceinline__ void operator()(const f32x4 (&acc)[2][2][4][2], const Unit& u, int wr, int wc, int fr, int fq) const {
        const bf16_t* ZP = this->ZP; asm volatile("" : "+s"(ZP)); bf16_t* MG = this->MG; asm volatile("" : "+s"(MG));
        const int row0 = u.pm * BM + wr * 64 + fr, col0 = u.pn * BM + wc * 32 + 8 * fq;
        u32x4 gq[2][4][2];
#pragma unroll
        for (int ai = 0; ai < 2; ++ai)
#pragma unroll
            for (int m = 0; m < 4; ++m) { const size_t pr = (size_t)prow_of(row0 + ai * HALF + m * 16) * NIN + C_GS;
#pragma unroll
                for (int bj = 0; bj < 2; ++bj) gq[ai][m][bj] = *(const u32x4*)(ZP + pr + col0 + bj * HALF); }
        __builtin_amdgcn_sched_barrier(0);
#pragma unroll
        for (int ai = 0; ai < 2; ++ai)
#pragma unroll
            for (int m = 0; m < 4; ++m) { const int row = row0 + ai * HALF + m * 16;
#pragma unroll
                for (int bj = 0; bj < 2; ++bj) { const int col = col0 + bj * HALF; const u32x4 gw = gq[ai][m][bj];
                    const f32x4 v0 = acc[ai][bj][m][0], v1 = acc[ai][bj][m][1]; u32x4 w;
                    w.x = cvt_pk_bf16(sigmoidf(bf_lo(gw.x)) * v0[0], sigmoidf(bf_hi(gw.x)) * v0[1]); w.y = cvt_pk_bf16(sigmoidf(bf_lo(gw.y)) * v0[2], sigmoidf(bf_hi(gw.y)) * v0[3]);
                    w.z = cvt_pk_bf16(sigmoidf(bf_lo(gw.z)) * v1[0], sigmoidf(bf_hi(gw.z)) * v1[1]); w.w = cvt_pk_bf16(sigmoidf(bf_lo(gw.w)) * v1[2], sigmoidf(bf_hi(gw.w)) * v1[3]);
                    *(u32x4*)(MG + (size_t)row * DM + col) = w; } }
    }
};
struct EpiWo {
    static constexpr bool PERM = true;
    float* U; const bf16_t* H0;
    __device__ __forceinline__ void operator()(const f32x4 (&acc)[2][2][4][2], const Unit& u, int wr, int wc, int fr, int fq) const {
        const int row0 = u.pm * BM + wr * 64 + fr, col0 = u.pn * BM + wc * 32 + 8 * fq;
#pragma unroll
        for (int ai = 0; ai < 2; ++ai) {
            u32x4 hq[4][2];
#pragma unroll
            for (int m = 0; m < 4; ++m) { const size_t pr = (size_t)prow_of(row0 + ai * HALF + m * 16) * DM;
#pragma unroll
                for (int bj = 0; bj < 2; ++bj) hq[m][bj] = *(const u32x4*)(H0 + pr + col0 + bj * HALF); }
            __builtin_amdgcn_sched_barrier(0);
#pragma unroll
            for (int m = 0; m < 4; ++m) { const int row = row0 + ai * HALF + m * 16;
#pragma unroll
                for (int bj = 0; bj < 2; ++bj) { const int c = col0 + bj * HALF; const u32x4 h = hq[m][bj];
                    *(f32x4*)(U + (size_t)row * DM + c) = (f32x4){bf_lo(h.x), bf_hi(h.x), bf_lo(h.y), bf_hi(h.y)} * ALPHA + acc[ai][bj][m][0];
                    *(f32x4*)(U + (size_t)row * DM + c + 4) = (f32x4){bf_lo(h.z), bf_hi(h.z), bf_lo(h.w), bf_hi(h.w)} * ALPHA + acc[ai][bj][m][1]; } }
            __builtin_amdgcn_sched_barrier(0);
        }
    }
};
struct EpiGateUp {
    static constexpr bool PERM = true;
    bf16_t* HID;
    __device__ __forceinline__ void operator()(const f32x4 (&acc)[2][2][4][2], const Unit& u, int wr, int wc, int fr, int fq) const {
        const int pos0 = u.pm * BM + wr * 64 + fr, col0 = u.pn * HALF + wc * 32 + 8 * fq;
#pragma unroll
        for (int ai = 0; ai < 2; ++ai)
#pragma unroll
            for (int m = 0; m < 4; ++m) { const int pos = pos0 + ai * HALF + m * 16;
                const f32x4 g0 = acc[ai][0][m][0], g1 = acc[ai][0][m][1], u0 = acc[ai][1][m][0], u1 = acc[ai][1][m][1]; u32x4 w;
                w.x = cvt_pk_bf16(siluf(g0[0]) * u0[0], siluf(g0[1]) * u0[1]); w.y = cvt_pk_bf16(siluf(g0[2]) * u0[2], siluf(g0[3]) * u0[3]);
                w.z = cvt_pk_bf16(siluf(g1[0]) * u1[0], siluf(g1[1]) * u1[1]); w.w = cvt_pk_bf16(siluf(g1[2]) * u1[2], siluf(g1[3]) * u1[3]);
                *(u32x4*)(HID + (size_t)pos * DE + col0) = w; }
    }
};
struct MoeTiles { const PG8_LAS int* te; const PG8_LAS int* tf; const PG8_LAS int* tn; const int* list_ent; const float* list_w; };
struct EpiDown {
    static constexpr bool PERM = true;
    bf16_t* Y; MoeTiles T;
    __device__ __forceinline__ void operator()(const f32x4 (&acc)[2][2][4][2], const Unit& u, int wr, int wc, int fr, int fq) const {
        const int r0 = wr * 64 + fr, col0 = u.pn * BM + wc * 32 + 8 * fq;
        const int e = T.te[u.pm], first = T.tf[u.pm], nv = T.tn[u.pm];
#pragma unroll
        for (int ai = 0; ai < 2; ++ai) {
            int ent[4]; float wt[4];
#pragma unroll
            for (int m = 0; m < 4; ++m) { const int r = r0 + ai * HALF + m * 16, rc = r < nv ? r : nv - 1;
                ent[m] = T.list_ent[e * MR + first + rc]; wt[m] = T.list_w[e * MR + first + rc]; }
#pragma unroll
            for (int m = 0; m < 4; ++m) { const int r = r0 + ai * HALF + m * 16;
                if (r < nv) {
#pragma unroll
                    for (int bj = 0; bj < 2; ++bj) { const f32x4 v0 = acc[ai][bj][m][0] * wt[m], v1 = acc[ai][bj][m][1] * wt[m]; u32x4 w;
                        w.x = cvt_pk_bf16(v0[0], v0[1]); w.y = cvt_pk_bf16(v0[2], v0[3]); w.z = cvt_pk_bf16(v1[0], v1[1]); w.w = cvt_pk_bf16(v1[2], v1[3]);
                        *(u32x4*)(Y + (size_t)ent[m] * DM + col0 + bj * HALF) = w; } } }
        }
    }
};
struct MoeOrder {
    int nN, nwg, G, c; const bf16_t* A; int lda; const bf16_t* Bt; size_t b_stride; int ldb; MoeTiles T; bool gather;
    int base; unsigned* arr; int arr_ui;
    __device__ bool next(int i, Unit& u) const { const long L = (long)i * G + c + base; if (L >= nwg) return false; u.pm = (int)(L / nN); u.pn = (int)(L % nN); return true; }
    __device__ __forceinline__ const char* a_base(const Unit& u) const { return gather ? (const char*)A : (const char*)(A + (size_t)u.pm * BM * lda); }
    __device__ __forceinline__ const char* b_base(const Unit& u) const { return (const char*)(Bt + (size_t)T.te[u.pm] * b_stride + (size_t)u.pn * BM * ldb); }
    __device__ __forceinline__ const char* w_base(const Unit& u, const WF32& wf, int h) const { return (const char*)((h ? wf.W1 : wf.W0) + (size_t)T.te[u.pm] * wf.estride + (size_t)u.pn * wf.pn_step); }
    __device__ __forceinline__ bool half(const Unit& u) const { return T.tn[u.pm] <= HALF; }
    __device__ __forceinline__ int a_row(const Unit& u, int r) const { const int idx = T.list_ent[T.te[u.pm] * MR + T.tf[u.pm] + (r < T.tn[u.pm] ? r : 0)]; return r < T.tn[u.pm] ? (idx >> 1) : 0; }
};
}

#define XB_TMO      128
#define XB_XCNT(j)  (256  + 64 * (j))
#define XB_XSUB(j)  (1280 + 64 * (j))
#define XB_XGEN(j)  (2304 + 64 * (j))
#define XB_TOP      3328
#define XB_TOPGEN   3392
#define XCD_BAR_WORDS 3456
#define XB_SPIN_CAP (1u << 18)
__device__ __forceinline__ unsigned xb_ld(unsigned* p)              { return __hip_atomic_load(p, __ATOMIC_RELAXED, __HIP_MEMORY_SCOPE_AGENT); }
__device__ __forceinline__ unsigned xb_add(unsigned* p, unsigned v) { return __hip_atomic_fetch_add(p, v, __ATOMIC_RELAXED, __HIP_MEMORY_SCOPE_AGENT); }
__device__ __forceinline__ unsigned xb_xcc_id() { return (unsigned)__builtin_amdgcn_s_getreg((3 << 11) | 20) & 0xFu; }
#define XB_SPIN(cond, bar) do { unsigned _sp = 0; while (cond) { __builtin_amdgcn_s_sleep(1); \
    if ((++_sp & 255u) == 0u) { if (xb_ld(&(bar)[XB_TMO])) break; if (_sp > XB_SPIN_CAP) { atomicAdd(&(bar)[XB_TMO], 1u); break; } } } } while (0)
struct XcdBarrier { unsigned* bar; unsigned x; volatile LAS unsigned* st; };
__device__ __forceinline__ XcdBarrier xcd_barrier_post(unsigned* bar, volatile LAS unsigned* st) {
    XcdBarrier b; b.bar = bar; b.x = xb_xcc_id(); b.st = st;
    if (threadIdx.x == 0) (void)xb_add(&bar[XB_XCNT(b.x)], 1u);
    return b;
}
__device__ __forceinline__ void xcd_barrier_complete(unsigned* bar, unsigned x, unsigned& nloc, unsigned& nx) {
    const unsigned G = gridDim.x * gridDim.y * gridDim.z;
    unsigned sum, cnt, mine, sp = 0u;
    for (;;) {
        sum = 0u; cnt = 0u; mine = 0u;
#pragma unroll
        for (unsigned j = 0; j < 16; ++j) { const unsigned c = xb_ld(&bar[XB_XCNT(j)]); sum += c; cnt += (c > 0u) ? 1u : 0u; mine = (j == x) ? c : mine; }
        if (sum == G) break;
        __builtin_amdgcn_s_sleep(1);
        if ((++sp & 255u) == 0u) { if (xb_ld(&bar[XB_TMO])) break; if (sp > XB_SPIN_CAP) { atomicAdd(&bar[XB_TMO], 1u); break; } }
    }
    nloc = mine > 0u ? mine : 1u; nx = cnt > 0u ? cnt : 1u;
}
__device__ __forceinline__ void xcd_barrier(const XcdBarrier& b) {
    asm volatile("s_waitcnt vmcnt(0)" ::: "memory");
    __syncthreads();
    if (threadIdx.x == 0) {
        unsigned* bar = b.bar;
        __builtin_amdgcn_s_waitcnt(0);
        unsigned nloc = b.st[0], nx = b.st[1];
        if (nloc == 0u) { xcd_barrier_complete(bar, b.x, nloc, nx); b.st[0] = nloc; b.st[1] = nx; }
        const unsigned old = xb_add(&bar[XB_XSUB(b.x)], 1u);
        const unsigned gen = old / nloc;
        if (old + 1u == (gen + 1u) * nloc) {
            __builtin_amdgcn_fence(__ATOMIC_RELEASE, "agent");
            asm volatile("s_waitcnt vmcnt(0)" ::: "memory");
            const unsigned og = xb_add(&bar[XB_TOP], 1u);
            const unsigned tg = og / nx;
            if (og + 1u == (tg + 1u) * nx) xb_add(&bar[XB_TOPGEN], 1u);
            else XB_SPIN(xb_ld(&bar[XB_TOPGEN]) == tg, bar);
            __builtin_amdgcn_fence(__ATOMIC_ACQUIRE, "agent");
            xb_add(&bar[XB_XGEN(b.x)], 1u);
            asm volatile("s_waitcnt vmcnt(0)" ::: "memory");
        } else {
            XB_SPIN(xb_ld(&bar[XB_XGEN(b.x)]) == gen, bar);
            __builtin_amdgcn_fence(__ATOMIC_ACQUIRE, "agent");
            asm volatile("s_waitcnt vmcnt(0)" ::: "memory");
        }
    }
    __syncthreads();
}

DEVINL void tr_item(const float* __restrict__ W, int ld, int c0, int k0, bf16_t* __restrict__ WT, size_t drow0, int K, LAS float* scr, int lane, bool zero) {
#pragma unroll
    for (int i = 0; i < 8; ++i) { const int kk = 8 * i + (lane >> 3), cc = 4 * (lane & 7);
        const pg8::f32x4 w4 = zero ? (pg8::f32x4){0.f, 0.f, 0.f, 0.f} : __builtin_nontemporal_load((const pg8::f32x4*)(W + (size_t)(k0 + kk) * ld + c0 + cc));
        scr[kk * 33 + cc] = w4[0]; scr[kk * 33 + cc + 1] = w4[1]; scr[kk * 33 + cc + 2] = w4[2]; scr[kk * 33 + cc + 3] = w4[3]; }
    LDS_WAIT();
    const int c = lane & 7;
#pragma unroll
    for (int j = 0; j < 4; ++j) { const int n = (lane >> 3) + 8 * j; const LAS float* s = scr + (8 * c) * 33 + n;
        uint4 o; o.x = pk2(s[0 * 33], s[1 * 33]); o.y = pk2(s[2 * 33], s[3 * 33]); o.z = pk2(s[4 * 33], s[5 * 33]); o.w = pk2(s[6 * 33], s[7 * 33]);
        *(uint4*)(WT + (drow0 + n) * (size_t)K + k0 + 8 * c) = o; }
    LDS_WAIT();
}
struct P { const float* in[26]; float* out; unsigned char* ws; int ph_lo, ph_hi; };

DEVINL void phase_weights(const P& p, LAS float* scr, int gw, int NGW, int lane, bool moe, int it0 = 0, int it1 = 1 << 30) {
    unsigned char* ws = p.ws;
    constexpr int I_IN = 32 * 344, I_BRA = 16 * 64, I_BRS = 32 * 64, I_O = 32 * 64, I_GU = 64 * 32 * 32, I_DN = 64 * 8 * 64;
    constexpr int NDENSE = I_IN + I_BRA + I_BRS + I_O, NMOE = I_GU + I_DN;
    const int itend = (moe ? NMOE : NDENSE) < it1 ? (moe ? NMOE : NDENSE) : it1;
    for (int it = it0 + gw; it < itend; it += NGW) {
        int r = moe ? it + NDENSE : it;
        if (r < I_IN) { const int kb = r / 344, nb = r % 344, n = nb * 32; int c0 = n; bool zero = false;
            if (n < 6656) c0 = n; else if (n < 10752) c0 = n + 32; else if (n < 10784) c0 = n - 4096; else { zero = true; c0 = 0; }
            tr_item(p.in[4], 10784, c0, kb * 64, (bf16_t*)(ws + WS_WIN), (size_t)n, DM, scr, lane, zero); continue; } r -= I_IN;
        if (r < I_BRA) { const int kb = r / 64, nb = r % 64; tr_item(p.in[12], DM, nb * 32, kb * 64, (bf16_t*)(ws + WS_WBRA), (size_t)nb * 32, 3072, scr, lane, false); continue; } r -= I_BRA;
        if (r < I_BRS) { const int kb = r / 64, nb = r % 64; tr_item(p.in[13], DM, nb * 32, kb * 64, (bf16_t*)(ws + WS_WBRA) + 1024, (size_t)nb * 32, 3072, scr, lane, false); continue; } r -= I_BRS;
        if (r < I_O) { const int kb = r / 64, nb = r % 64; tr_item(p.in[14], DM, nb * 32, kb * 64, (bf16_t*)(ws + WS_WO), (size_t)nb * 32, DM, scr, lane, false); continue; } r -= I_O;
        if (r < I_GU) { const int e = r >> 10, q = r & 1023, kb = q >> 5, nb = q & 31, pn = nb >> 3, w = nb & 7;
            const float* src = (w < 4 ? p.in[21] : p.in[22]) + (size_t)e * DM * DE;
            tr_item(src, DE, pn * 128 + (w & 3) * 32, kb * 64, (bf16_t*)(ws + WS_WGU), (size_t)e * 1024 + nb * 32, DM, scr, lane, false); continue; } r -= I_GU;
        { const int e = r >> 9, q = r & 511, kb = q >> 6, nb = q & 63;
            tr_item(p.in[23] + (size_t)e * DE * DM, DM, nb * 32, kb * 64, (bf16_t*)(ws + WS_WDN), (size_t)e * DM + nb * 32, DE, scr, lane, false); }
    }
}
DEVINL void ln0_row(const P& p, int R, int lane, const float4 (&g0r)[8], const float4 (&b0r)[8]) {
    const int b = R / LP, pp = R % LP;
    uint2* orow = (uint2*)((bf16_t*)(p.ws + WS_H0) + (size_t)R * DM);
    if (pp < 112) {
#pragma unroll
        for (int j = 0; j < 8; ++j) orow[lane + 64 * j] = make_uint2(0u, 0u);
        return;
    }
    const float* src = pp < 128 ? p.in[1] + (size_t)(pp - 112) * DM : p.in[0] + ((size_t)b * SEQ + (pp - 128)) * DM;
    float4 v[8]; float s = 0.f;
#pragma unroll
    for (int j = 0; j < 8; ++j) { v[j] = ((const float4*)src)[lane + 64 * j]; s += (v[j].x + v[j].y) + (v[j].z + v[j].w); }
    const float mean = wave_sum(s) * (1.f / DM); float q = 0.f;
#pragma unroll
    for (int j = 0; j < 8; ++j) { v[j].x -= mean; v[j].y -= mean; v[j].z -= mean; v[j].w -= mean; q += (v[j].x * v[j].x + v[j].y * v[j].y) + (v[j].z * v[j].z + v[j].w * v[j].w); }
    const float rstd = 1.f / sqrtf(wave_sum(q) * (1.f / DM) + LN_EPS);
#pragma unroll
    for (int j = 0; j < 8; ++j) {
        const float4 gg = g0r[j], bb = b0r[j];
        orow[lane + 64 * j] = make_uint2(pk2(v[j].x * rstd * gg.x + bb.x, v[j].y * rstd * gg.y + bb.y), pk2(v[j].z * rstd * gg.z + bb.z, v[j].w * rstd * gg.w + bb.w));
    }
    if (pp >= 128 && lane == 0) { float* rowstat = (float*)(p.ws + OFF_ROWSTAT); const int r = b * SEQ + pp - 128; rowstat[2 * r] = mean; rowstat[2 * r + 1] = rstd; }
}
template <bool DISPATCH> DEVINL void ln1_router_row(const P& p, int r, int rnext, float4 (&vin)[8], const float4 (&g1r)[8], const float4 (&b1r)[8], int lane, LAS float* scr, const LAS float* wrgl, LAS int* res) {
    const float* U = (const float*)(p.ws + WS_U); bf16_t* H1B = (bf16_t*)(p.ws + WS_H1B);
    const float* brg = p.in[18]; const float* bre = p.in[20];
    const float* wreg = (const float*)(p.ws + OFF_WREG);
    float4 v[8]; float s = 0.f;
#pragma unroll
    for (int j = 0; j < 8; ++j) { v[j] = vin[j]; s += (v[j].x + v[j].y) + (v[j].z + v[j].w); }
    if (rnext >= 0) {
        const float4* upn = (const float4*)(U + (size_t)rnext * DM);
#pragma unroll
        for (int j = 0; j < 8; ++j) vin[j] = upn[lane + 64 * j]; }
    const float mean = wave_sum(s) * (1.f / DM); float q = 0.f;
#pragma unroll
    for (int j = 0; j < 8; ++j) { v[j].x -= mean; v[j].y -= mean; v[j].z -= mean; v[j].w -= mean; q += (v[j].x * v[j].x + v[j].y * v[j].y) + (v[j].z * v[j].z + v[j].w * v[j].w); }
    const float rstd = 1.f / sqrtf(wave_sum(q) * (1.f / DM) + LN_EPS);
    if (DISPATCH && lane == 0) { float* rs1 = (float*)(p.ws + OFF_ROWSTAT1); rs1[2 * r] = mean; rs1[2 * r + 1] = rstd; }
    uint2* hb = (uint2*)(H1B + (size_t)r * DM);
#pragma unroll
    for (int j = 0; j < 8; ++j) {
        const float4 gg = g1r[j], bb = b1r[j];
        v[j].x = v[j].x * rstd * gg.x + bb.x; v[j].y = v[j].y * rstd * gg.y + bb.y; v[j].z = v[j].z * rstd * gg.z + bb.z; v[j].w = v[j].w * rstd * gg.w + bb.w;
        if (DISPATCH) hb[lane + 64 * j] = make_uint2(pk2(v[j].x, v[j].y), pk2(v[j].z, v[j].w));
        *(LAS pg8::f32x4*)(scr + 4 * (lane + 64 * j)) = (pg8::f32x4){v[j].x, v[j].y, v[j].z, v[j].w};
    }
    LDS_WAIT();
    float lg[8];
#pragma unroll
    for (int c = 0; c < 8; ++c) lg[c] = 0.f;
#pragma unroll 8
    for (int t = 0; t < 32; ++t) {
        const int i = lane + 64 * t; const float h = scr[i];
        const pg8::f32x4 w0 = *(const LAS pg8::f32x4*)(wrgl + i * 8), w1 = *(const LAS pg8::f32x4*)(wrgl + i * 8 + 4);
        lg[0] += h * w0[0]; lg[1] += h * w0[1]; lg[2] += h * w0[2]; lg[3] += h * w0[3];
        lg[4] += h * w1[0]; lg[5] += h * w1[1]; lg[6] += h * w1[2]; lg[7] += h * w1[3];
    }
#pragma unroll
    for (int c = 0; c < 8; ++c) lg[c] = wave_sum(lg[c]) + brg[c];
    int gi = 0; float gm = lg[0];
#pragma unroll
    for (int c = 1; c < 8; ++c) if (lg[c] > gm) { gm = lg[c]; gi = c; }
    float den = 0.f;
#pragma unroll
    for (int c = 0; c < 8; ++c) den += __expf(lg[c] - gm);
    const float ptop = 1.f / den;
    float sel[8];
#pragma unroll
    for (int c = 0; c < 8; ++c) sel[c] = 0.f;
    const float* wgp = wreg + ((size_t)gi * DM + lane) * 8;
#pragma unroll 8
    for (int t = 0; t < 32; ++t) {
        const float h = scr[lane + 64 * t];
        const float4 w0 = *(const float4*)(wgp + (size_t)t * 512), w1 = *(const float4*)(wgp + (size_t)t * 512 + 4);
        sel[0] += h * w0.x; sel[1] += h * w0.y; sel[2] += h * w0.z; sel[3] += h * w0.w;
        sel[4] += h * w1.x; sel[5] += h * w1.y; sel[6] += h * w1.z; sel[7] += h * w1.w;
    }
    {   const float4 be0 = ((const float4*)(bre + gi * 8))[0], be1 = ((const float4*)(bre + gi * 8))[1];
        sel[0] = wave_sum(sel[0]) + be0.x; sel[1] = wave_sum(sel[1]) + be0.y; sel[2] = wave_sum(sel[2]) + be0.z; sel[3] = wave_sum(sel[3]) + be0.w;
        sel[4] = wave_sum(sel[4]) + be1.x; sel[5] = wave_sum(sel[5]) + be1.y; sel[6] = wave_sum(sel[6]) + be1.z; sel[7] = wave_sum(sel[7]) + be1.w; }
    LDS_WAIT();
    int i1 = 0; float m1 = sel[0];
#pragma unroll
    for (int jj = 1; jj < 8; ++jj) if (sel[jj] > m1) { m1 = sel[jj]; i1 = jj; }
    int i2 = -1; float m2 = -3.0e38f;
#pragma unroll
    for (int jj = 0; jj < 8; ++jj) if (jj != i1 && sel[jj] > m2) { m2 = sel[jj]; i2 = jj; }
    const float e2 = __expf(m2 - m1), w1 = ptop / (1.f + e2), w2 = ptop * e2 / (1.f + e2);
    if (!DISPATCH) { asm volatile("" :: "v"(w1), "v"(w2), "v"(i1), "v"(i2)); return; }
    if (lane == 0) { res[0] = gi * 8 + i1; res[1] = gi * 8 + i2; res[2] = __float_as_int(w1); res[3] = __float_as_int(w2); }
}
DEVINL void ln2_row(const P& p, int r, int lane, const float4 (&g2r)[8], const float4 (&b2r)[8]) {
    const bf16_t* H1B = (const bf16_t*)(p.ws + WS_H1B); const bf16_t* Y = (const bf16_t*)(p.ws + WS_Y);
    const uint4* hp = (const uint4*)(H1B + (size_t)r * DM);
    const uint4* y0 = (const uint4*)(Y + (size_t)(2 * r) * DM); const uint4* y1 = (const uint4*)(Y + (size_t)(2 * r + 1) * DM);
    float4 v[8]; float s = 0.f;
#pragma unroll
    for (int j = 0; j < 4; ++j) {
        const uint4 u = hp[lane + 64 * j], a = y0[lane + 64 * j], c = y1[lane + 64 * j];
        v[2 * j].x = ALPHA * bf_lo(u.x) + bf_lo(a.x) + bf_lo(c.x); v[2 * j].y = ALPHA * bf_hi(u.x) + bf_hi(a.x) + bf_hi(c.x);
        v[2 * j].z = ALPHA * bf_lo(u.y) + bf_lo(a.y) + bf_lo(c.y); v[2 * j].w = ALPHA * bf_hi(u.y) + bf_hi(a.y) + bf_hi(c.y);
        v[2 * j + 1].x = ALPHA * bf_lo(u.z) + bf_lo(a.z) + bf_lo(c.z); v[2 * j + 1].y = ALPHA * bf_hi(u.z) + bf_hi(a.z) + bf_hi(c.z);
        v[2 * j + 1].z = ALPHA * bf_lo(u.w) + bf_lo(a.w) + bf_lo(c.w); v[2 * j + 1].w = ALPHA * bf_hi(u.w) + bf_hi(a.w) + bf_hi(c.w);
        s += ((v[2 * j].x + v[2 * j].y) + (v[2 * j].z + v[2 * j].w)) + ((v[2 * j + 1].x + v[2 * j + 1].y) + (v[2 * j + 1].z + v[2 * j + 1].w));
    }
    const float mean = wave_sum(s) * (1.f / DM); float q = 0.f;
#pragma unroll
    for (int j = 0; j < 8; ++j) { v[j].x -= mean; v[j].y -= mean; v[j].z -= mean; v[j].w -= mean; q += (v[j].x * v[j].x + v[j].y * v[j].y) + (v[j].z * v[j].z + v[j].w * v[j].w); }
    const float rstd = 1.f / sqrtf(wave_sum(q) * (1.f / DM) + LN_EPS);
    float4* op = (float4*)(p.out + (size_t)r * DM);
#pragma unroll
    for (int j = 0; j < 8; ++j) {
        const float4 gg = g2r[j], bb = b2r[j];
        op[2 * (lane + 64 * (j >> 1)) + (j & 1)] = make_float4(v[j].x * rstd * gg.x + bb.x, v[j].y * rstd * gg.y + bb.y, v[j].z * rstd * gg.z + bb.z, v[j].w * rstd * gg.w + bb.w);
    }
}


typedef unsigned u32x4_t __attribute__((ext_vector_type(4)));
typedef unsigned u32x2_t __attribute__((ext_vector_type(2)));
typedef float f32x4_t __attribute__((ext_vector_type(4)));
DEVINL bf16x8 pack8(const float* v) { u32x4_t w; w.x = cvtpk(v[0], v[1]); w.y = cvtpk(v[2], v[3]); w.z = cvtpk(v[4], v[5]); w.w = cvtpk(v[6], v[7]); return __builtin_bit_cast(bf16x8, w); }
#define MFMA32(a, b, c) __builtin_amdgcn_mfma_f32_32x32x16_bf16((a), (b), (c), 0, 0, 0)
constexpr int SSTR = 136;
constexpr int XSTR = 132;
constexpr int SSD_B = 0, SSD_C = 128 * SSTR * 2, SSD_DT = 2 * 128 * SSTR * 2, SSD_ACS = SSD_DT + 4096, SSD_DTW = SSD_ACS + 4096, SSD_RED = SSD_DTW + 4096, SSD_WV = SSD_RED + 4096, SSD_WV_BYTES = 32 * XSTR * 2;
constexpr size_t S_CHUNK = (size_t)SH * SP * SN;
constexpr int NCH = 65;
constexpr size_t BC_TILE = 128 * 128;

DEVINL void conv_block2(const P& p, int b, int c, int col0, int cch0, LAS bf16_t* dst, int tid) {
    const int cp = tid & 63, seg = tid >> 6, ch = cch0 + 2 * cp;
    const float* cw = p.in[5];
    const f32x2_t w0 = *(const f32x2_t*)(cw + ch), w1 = *(const f32x2_t*)(cw + 3072 + ch), w2 = *(const f32x2_t*)(cw + 2 * 3072 + ch), w3 = *(const f32x2_t*)(cw + 3 * 3072 + ch), bs = *(const f32x2_t*)(p.in[6] + ch);
    const bf16_t* base = (const bf16_t*)(p.ws + WS_ZP) + (size_t)b * LP * NIN + col0 + 2 * cp;
    const int pr0 = 128 * c + 16 * seg - 3;
    unsigned raw[19];
#pragma unroll
    for (int i = 0; i < 19; ++i) { const int q = pr0 + i; raw[i] = *(const unsigned*)(base + (size_t)(q > 0 ? q : 0) * NIN); }
#pragma unroll
    for (int i = 0; i < 16; ++i) {
        const float va = siluf(w0[0] * bf_lo(raw[i]) + w1[0] * bf_lo(raw[i + 1]) + w2[0] * bf_lo(raw[i + 2]) + w3[0] * bf_lo(raw[i + 3]) + bs[0]);
        const float vb = siluf(w0[1] * bf_hi(raw[i]) + w1[1] * bf_hi(raw[i + 1]) + w2[1] * bf_hi(raw[i + 2]) + w3[1] * bf_hi(raw[i + 3]) + bs[1]);
        *(LAS unsigned*)(dst + (16 * seg + i) * SSTR + 2 * cp) = cvtpk(va, vb);
    }
}
DEVINL void stage_xT(const P& p, int b, int c, int h, int pt, LAS bf16_t* XT, int lane) {
    const int cp = lane & 15, seg = lane >> 4, ch = h * 64 + pt * 32 + 2 * cp;
    const float* cw = p.in[5];
    const f32x2_t w0 = *(const f32x2_t*)(cw + ch), w1 = *(const f32x2_t*)(cw + 3072 + ch), w2 = *(const f32x2_t*)(cw + 2 * 3072 + ch), w3 = *(const f32x2_t*)(cw + 3 * 3072 + ch), bs = *(const f32x2_t*)(p.in[6] + ch);
    const bf16_t* base = (const bf16_t*)(p.ws + WS_ZP) + (size_t)b * LP * NIN + C_X + ch;
    const int pr0 = 128 * c + 32 * seg - 3;
    unsigned raw[35];
#pragma unroll
    for (int i = 0; i < 35; ++i) { const int q = pr0 + i; raw[i] = *(const unsigned*)(base + (size_t)(q > 0 ? q : 0) * NIN); }
#pragma unroll
    for (int i = 0; i < 32; i += 2) {
        float va[2], vb[2];
#pragma unroll
        for (int e = 0; e < 2; ++e) {
            va[e] = siluf(w0[0] * bf_lo(raw[i + e]) + w1[0] * bf_lo(raw[i + e + 1]) + w2[0] * bf_lo(raw[i + e + 2]) + w3[0] * bf_lo(raw[i + e + 3]) + bs[0]);
            vb[e] = siluf(w0[1] * bf_hi(raw[i + e]) + w1[1] * bf_hi(raw[i + e + 1]) + w2[1] * bf_hi(raw[i + e + 2]) + w3[1] * bf_hi(raw[i + e + 3]) + bs[1]);
        }
        const int sidx = 32 * seg + i;
        *(LAS unsigned*)(XT + (2 * cp) * XSTR + sidx) = cvtpk(va[0], va[1]);
        *(LAS unsigned*)(XT + (2 * cp + 1) * XSTR + sidx) = cvtpk(vb[0], vb[1]);
    }
    LDS_WAIT();
}
DEVINL void conv_pre_item(const P& p, int b, int c, int g, LAS unsigned char* lds, int tid, int w, int lane) {
    asm volatile("" : "+v"(tid)); asm volatile("" : "+s"(w)); lane = tid & 63;
    const int bc = b * NCH + c, h = g * 8 + w;
    LAS bf16_t* Bc = (LAS bf16_t*)(lds + SSD_B); LAS bf16_t* Cc = (LAS bf16_t*)(lds + SSD_C);
    __syncthreads();
    conv_block2(p, b, c, C_B + g * 128, 2048 + g * 128, Bc, tid);
    conv_block2(p, b, c, C_C + g * 128, 2560 + g * 128, Cc, tid);
    LAS bf16_t* XT = (LAS bf16_t*)(lds + SSD_WV + w * SSD_WV_BYTES);
#pragma unroll 1
    for (int pt = 0; pt < 2; ++pt) {
        stage_xT(p, b, c, h, pt, XT, lane);
        bf16_t* dst = (bf16_t*)(p.ws + WS_XCT) + ((size_t)(bc * SH + h) * SP + pt * 32) * 128;
#pragma unroll
        for (int k = 0; k < 8; ++k) { const int idx = lane + 64 * k, row = idx >> 4, j = idx & 15;
            const u32x2_t a = *(const LAS u32x2_t*)(XT + row * XSTR + j * 8), bq = *(const LAS u32x2_t*)(XT + row * XSTR + j * 8 + 4);
            *(u32x4_t*)(dst + row * 128 + j * 8) = (u32x4_t){a.x, a.y, bq.x, bq.y}; }
        LDS_WAIT();
    }
    LDS_WAIT();
    __syncthreads();
    const size_t tile = (size_t)(bc * SG + g) * BC_TILE;
    bf16_t* BCg = (bf16_t*)(p.ws + WS_BCC) + tile; bf16_t* CCg = (bf16_t*)(p.ws + WS_CCC) + tile; bf16_t* BTg = (bf16_t*)(p.ws + WS_BTT) + tile;
#pragma unroll
    for (int k = 0; k < 4; ++k) { const int idx = tid + 512 * k, l = idx >> 4, j = idx & 15;
        *(u32x4_t*)(BCg + l * 128 + j * 8) = *(const LAS u32x4_t*)(Bc + l * SSTR + j * 8);
        *(u32x4_t*)(CCg + l * 128 + j * 8) = *(const LAS u32x4_t*)(Cc + l * SSTR + j * 8); }
#pragma unroll
    for (int k = 0; k < 4; ++k) { const int idx = tid + 512 * k, n = idx >> 4, lc = idx & 15;
        unsigned short e[8];
#pragma unroll
        for (int q = 0; q < 8; ++q) e[q] = Bc[(8 * lc + q) * SSTR + n];
        *(u32x4_t*)(BTg + n * 128 + 8 * lc) = (u32x4_t){(unsigned)e[0] | ((unsigned)e[1] << 16), (unsigned)e[2] | ((unsigned)e[3] << 16), (unsigned)e[4] | ((unsigned)e[5] << 16), (unsigned)e[6] | ((unsigned)e[7] << 16)}; }
    asm volatile("s_waitcnt vmcnt(0)" ::: "memory");
}
DEVINL void conv_c64_piece(const P& p, int piece, LAS unsigned char* lds, int w, int lane) {
    if (piece < 128) {
        const int b = piece >> 6, h = (piece >> 1) & 31, pt = piece & 1, bc = b * NCH + 64;
        LAS bf16_t* XT = (LAS bf16_t*)(lds + SSD_WV + w * SSD_WV_BYTES);
        stage_xT(p, b, 64, h, pt, XT, lane);
        bf16_t* dst = (bf16_t*)(p.ws + WS_XCT) + ((size_t)(bc * SH + h) * SP + pt * 32) * 128;
#pragma unroll
        for (int k = 0; k < 8; ++k) { const int idx = lane + 64 * k, row = idx >> 4, j = idx & 15;
            const u32x2_t a = *(const LAS u32x2_t*)(XT + row * XSTR + j * 8), bq = *(const LAS u32x2_t*)(XT + row * XSTR + j * 8 + 4);
            *(u32x4_t*)(dst + row * 128 + j * 8) = (u32x4_t){a.x, a.y, bq.x, bq.y}; }
        LDS_WAIT();
    } else {
        const int q = piece - 128, seg = q & 7, which = (q >> 3) & 1, g = (q >> 4) & 3, b = q >> 6, bc = b * NCH + 64;
        const int col0 = (which ? C_C : C_B) + g * 128, ch = (which ? 2560 : 2048) + g * 128 + 2 * lane;
        const float* cw = p.in[5];
        const f32x2_t w0 = *(const f32x2_t*)(cw + ch), w1 = *(const f32x2_t*)(cw + 3072 + ch), w2 = *(const f32x2_t*)(cw + 2 * 3072 + ch), w3 = *(const f32x2_t*)(cw + 3 * 3072 + ch), bs = *(const f32x2_t*)(p.in[6] + ch);
        const bf16_t* base = (const bf16_t*)(p.ws + WS_ZP) + (size_t)b * LP * NIN + col0 + 2 * lane;
        const int pr0 = 128 * 64 + 16 * seg - 3;
        unsigned raw[19];
#pragma unroll
        for (int i = 0; i < 19; ++i) raw[i] = *(const unsigned*)(base + (size_t)(pr0 + i) * NIN);
        bf16_t* dst = (bf16_t*)(p.ws + (which ? WS_CCC : WS_BCC)) + (size_t)(bc * SG + g) * BC_TILE + (size_t)(16 * seg) * 128 + 2 * lane;
#pragma unroll
        for (int i = 0; i < 16; ++i) {
            const float va = siluf(w0[0] * bf_lo(raw[i]) + w1[0] * bf_lo(raw[i + 1]) + w2[0] * bf_lo(raw[i + 2]) + w3[0] * bf_lo(raw[i + 3]) + bs[0]);
            const float vb = siluf(w0[1] * bf_hi(raw[i]) + w1[1] * bf_hi(raw[i + 1]) + w2[1] * bf_hi(raw[i + 2]) + w3[1] * bf_hi(raw[i + 3]) + bs[1]);
            *(unsigned*)(dst + i * 128) = cvtpk(va, vb);
        }
    }
}
DEVINL void dt_scan(const P& p, int b, int c, int h, int w, int lane, LAS unsigned char* lds) {
    const bf16_t* ZP = (const bf16_t*)(p.ws + WS_ZP);
    const float dtb = p.in[7][h], a = -__expf(p.in[8][h]);
    LAS float* DT = (LAS float*)(lds + SSD_DT) + w * 128; LAS float* ACS = (LAS float*)(lds + SSD_ACS) + w * 128;
    float dt[2], cs[2];
#pragma unroll
    for (int k = 0; k < 2; ++k) { const int l = lane + 64 * k, pr = 128 * c + l;
        const float raw = bf2f(ZP[((size_t)b * LP + pr) * NIN + C_DT + h]) + dtb;
        dt[k] = (pr < 112) ? 0.f : (raw > 20.f ? raw : log1pf(__expf(raw))); cs[k] = dt[k] * a; }
#pragma unroll
    for (int d = 1; d < 64; d <<= 1) { const float t0 = __shfl_up(cs[0], d), t1 = __shfl_up(cs[1], d); if (lane >= d) { cs[0] += t0; cs[1] += t1; } }
    cs[1] += __shfl(cs[0], 63);
    DT[lane] = dt[0]; DT[lane + 64] = dt[1]; ACS[lane] = cs[0]; ACS[lane + 64] = cs[1];
    LDS_WAIT();
}

DEVINL void ssd1_item(const P& p, int item, LAS unsigned char* lds, int tid, int w, int lane) {
    asm volatile("" : "+v"(tid)); asm volatile("" : "+s"(w)); lane = tid & 63;
    const int g = item & 3, c = (item >> 2) & 63, b = item >> 8, h = g * 8 + w, half = lane >> 5, l31 = lane & 31, bc = b * NCH + c;
    LAS bf16_t* BcT = (LAS bf16_t*)(lds + SSD_B);
    __syncthreads();
    {   const bf16_t* BTg = (const bf16_t*)(p.ws + WS_BTT) + (size_t)(bc * SG + g) * BC_TILE;
#pragma unroll
        for (int k = 0; k < 4; ++k) { const int idx = tid + 512 * k, n = idx >> 4, j = idx & 15; *(LAS u32x4_t*)(BcT + n * SSTR + j * 8) = *(const u32x4_t*)(BTg + n * 128 + j * 8); } }
    dt_scan(p, b, c, h, w, lane, lds);
    LAS float* DT = (LAS float*)(lds + SSD_DT) + w * 128; LAS float* ACS = (LAS float*)(lds + SSD_ACS) + w * 128; LAS float* DTW = (LAS float*)(lds + SSD_DTW) + w * 128;
    const float aend = ACS[127];
    DTW[lane] = DT[lane] * __expf(aend - ACS[lane]); DTW[lane + 64] = DT[lane + 64] * __expf(aend - ACS[lane + 64]);
    if (lane == 0) ((float*)(p.ws + OFF_CD))[(b * 64 + c) * SH + h] = __expf(aend);
    LDS_WAIT();
    __syncthreads();
#pragma unroll 1
    for (int pt = 0; pt < 2; ++pt) {
        const bf16_t* xrow = (const bf16_t*)(p.ws + WS_XCT) + ((size_t)(bc * SH + h) * SP + pt * 32 + l31) * 128;
        f32x16 acc[4];
#pragma unroll
        for (int nt = 0; nt < 4; ++nt)
#pragma unroll
            for (int r = 0; r < 16; ++r) acc[nt][r] = 0.f;
#pragma unroll 4
        for (int ks = 0; ks < 8; ++ks) {
            const int lb = ks * 16 + 8 * half;
            const u32x4_t xr = *(const u32x4_t*)(xrow + lb);
            const f32x4_t d0 = *(const LAS f32x4_t*)(DTW + lb), d1 = *(const LAS f32x4_t*)(DTW + lb + 4);
            u32x4_t xs; xs.x = cvtpk(bf_lo(xr.x) * d0[0], bf_hi(xr.x) * d0[1]); xs.y = cvtpk(bf_lo(xr.y) * d0[2], bf_hi(xr.y) * d0[3]);
            xs.z = cvtpk(bf_lo(xr.z) * d1[0], bf_hi(xr.z) * d1[1]); xs.w = cvtpk(bf_lo(xr.w) * d1[2], bf_hi(xr.w) * d1[3]);
            const bf16x8 af = __builtin_bit_cast(bf16x8, xs);
#pragma unroll
            for (int nt = 0; nt < 4; ++nt) { const bf16x8 bfm = *(const LAS bf16x8*)(BcT + (nt * 32 + l31) * SSTR + lb); acc[nt] = MFMA32(af, bfm, acc[nt]); }
        }
        bf16_t* S = (bf16_t*)(p.ws + WS_SST) + ((size_t)(b * 64 + c) * SH + h) * (SP * SN);
#pragma unroll
        for (int nt = 0; nt < 4; ++nt)
#pragma unroll
            for (int r = 0; r < 16; r += 2) { const int pp = pt * 32 + (r & 3) + 8 * (r >> 2) + 4 * half; const unsigned cv = cvtpk(acc[nt][r], acc[nt][r + 1]);
                S[pp * SN + nt * 32 + l31] = (bf16_t)(cv & 0xffffu); S[(pp + 1) * SN + nt * 32 + l31] = (bf16_t)(cv >> 16); }
    }
}
DEVINL void ssd2_scan(const P& p, int gt) {
    const size_t e = (size_t)gt * 4; if (e >= 2 * S_CHUNK) return;
    const int b = (int)(e / S_CHUNK); const size_t rem = e % S_CHUNK; const int h = (int)(rem >> 13);
    const bf16_t* S = (const bf16_t*)(p.ws + WS_SST); bf16_t* PV = (bf16_t*)(p.ws + WS_PREV); const float* CD = (const float*)(p.ws + OFF_CD);
    float s0 = 0.f, s1 = 0.f, s2 = 0.f, s3 = 0.f;
#pragma unroll 8
    for (int c = 0; c < 64; ++c) {
        const size_t off = (size_t)(b * 64 + c) * S_CHUNK + rem;
        const uint2 v = *(const uint2*)(S + off); const float cd = CD[(b * 64 + c) * SH + h];
        s0 = s0 * cd + bf_lo(v.x); s1 = s1 * cd + bf_hi(v.x); s2 = s2 * cd + bf_lo(v.y); s3 = s3 * cd + bf_hi(v.y);
        *(uint2*)(PV + off) = make_uint2(cvtpk(s0, s1), cvtpk(s2, s3));
    }
}
DEVINL void ssd3_item(const P& p, int item, LAS unsigned char* lds, int tid, int w, int lane) {
    asm volatile("" : "+v"(tid)); asm volatile("" : "+s"(w)); lane = tid & 63;
    const int g = item & 3, c = ((item >> 2) & 63) + 1, b = item >> 8, h = g * 8 + w, half = lane >> 5, l31 = lane & 31, bc = b * NCH + c;
    LAS bf16_t* Bc = (LAS bf16_t*)(lds + SSD_B); LAS bf16_t* Cc = (LAS bf16_t*)(lds + SSD_C);
    __syncthreads();
    {   const size_t tile = (size_t)(bc * SG + g) * BC_TILE;
        const bf16_t* BCg = (const bf16_t*)(p.ws + WS_BCC) + tile; const bf16_t* CCg = (const bf16_t*)(p.ws + WS_CCC) + tile;
#pragma unroll
        for (int k = 0; k < 4; ++k) { const int idx = tid + 512 * k, l = idx >> 4, j = idx & 15;
            *(LAS u32x4_t*)(Bc + l * SSTR + j * 8) = *(const u32x4_t*)(BCg + l * 128 + j * 8);
            *(LAS u32x4_t*)(Cc + l * SSTR + j * 8) = *(const u32x4_t*)(CCg + l * 128 + j * 8); } }
    dt_scan(p, b, c, h, w, lane, lds);
    LAS float* DT = (LAS float*)(lds + SSD_DT) + w * 128; LAS float* ACS = (LAS float*)(lds + SSD_ACS) + w * 128;
    __syncthreads();
    const bf16_t* ZP = (const bf16_t*)(p.ws + WS_ZP);
    const bf16_t* PV = (const bf16_t*)(p.ws + WS_PREV) + ((size_t)(b * 64 + c - 1) * SH + h) * (SP * SN);
    const bf16_t* xrow = (const bf16_t*)(p.ws + WS_XCT) + ((size_t)(bc * SH + h) * SP + l31) * 128;
    const float dsk = p.in[9][h];
    f32x16 acc[2][4];
#pragma unroll
    for (int pt = 0; pt < 2; ++pt)
#pragma unroll
        for (int lt = 0; lt < 4; ++lt)
#pragma unroll
            for (int r = 0; r < 16; ++r) acc[pt][lt][r] = 0.f;
#pragma unroll 2
    for (int kn = 0; kn < 8; ++kn) {
        const int nb = kn * 16 + 8 * half;
        const bf16x8 a0 = *(const bf16x8*)(PV + (size_t)l31 * SN + nb), a1 = *(const bf16x8*)(PV + (size_t)(32 + l31) * SN + nb);
#pragma unroll
        for (int lt = 0; lt < 4; ++lt) { const bf16x8 cf = *(const LAS bf16x8*)(Cc + (lt * 32 + l31) * SSTR + nb); acc[0][lt] = MFMA32(a0, cf, acc[0][lt]); acc[1][lt] = MFMA32(a1, cf, acc[1][lt]); }
    }
#pragma unroll
    for (int lt = 0; lt < 4; ++lt) { const float ea = __expf(ACS[lt * 32 + l31]);
#pragma unroll
        for (int r = 0; r < 16; ++r) { acc[0][lt][r] *= ea; acc[1][lt][r] *= ea; } }
#pragma unroll 1
    for (int st = 0; st < 4; ++st) {
        int dd = l31 - 4 * half; asm volatile("" : "+v"(dd));
        bf16x8 xa[2][2];
#pragma unroll
        for (int pt = 0; pt < 2; ++pt)
#pragma unroll
            for (int ks = 0; ks < 2; ++ks) { const int s0 = st * 32 + 16 * ks + 4 * half;
                const u32x2_t x0 = *(const u32x2_t*)(xrow + pt * 32 * 128 + s0), x1 = *(const u32x2_t*)(xrow + pt * 32 * 128 + s0 + 8);
                xa[pt][ks] = __builtin_bit_cast(bf16x8, ((u32x4_t){x0.x, x0.y, x1.x, x1.y})); }
#pragma unroll
        for (int lt = 0; lt < 4; ++lt) { if (lt < st) continue;
            f32x16 ga;
#pragma unroll
            for (int r = 0; r < 16; ++r) ga[r] = 0.f;
#pragma unroll
            for (int kn = 0; kn < 8; ++kn) {
                const int nb = kn * 16 + 8 * half;
                const bf16x8 bfm = *(const LAS bf16x8*)(Bc + (st * 32 + l31) * SSTR + nb), cf = *(const LAS bf16x8*)(Cc + (lt * 32 + l31) * SSTR + nb);
                ga = MFMA32(bfm, cf, ga);
            }
            float mv[16]; const float acl = ACS[lt * 32 + l31];
#pragma unroll
            for (int q = 0; q < 4; ++q) { const f32x4_t a4 = *(const LAS f32x4_t*)(ACS + st * 32 + 8 * q + 4 * half), d4 = *(const LAS f32x4_t*)(DT + st * 32 + 8 * q + 4 * half);
#pragma unroll
                for (int i = 0; i < 4; ++i) { const int r = 4 * q + i;
                    float v = ga[r] * __expf(fminf(acl - a4[i], 0.f)) * d4[i];
                    if (lt == st) { v = (8 * q + i <= dd) ? v : 0.f; v += (8 * q + i == dd) ? dsk : 0.f; }
                    mv[r] = v; } }
            const bf16x8 b0 = pack8(mv), b1 = pack8(mv + 8);
            acc[0][lt] = MFMA32(xa[0][0], b0, acc[0][lt]); acc[1][lt] = MFMA32(xa[1][0], b0, acc[1][lt]);
            acc[0][lt] = MFMA32(xa[0][1], b1, acc[0][lt]); acc[1][lt] = MFMA32(xa[1][1], b1, acc[1][lt]);
        }
    }
    LAS bf16_t* ZT = (LAS bf16_t*)(lds + SSD_WV + w * SSD_WV_BYTES);
    const int rr = lane >> 2, cq = lane & 3;
    float ssq[4];
#pragma unroll
    for (int lt = 0; lt < 4; ++lt) ssq[lt] = 0.f;
#pragma unroll
    for (int pt = 0; pt < 2; ++pt) {
#pragma unroll
        for (int k0 = 0; k0 < 8; k0 += 4) {
            u32x4_t zl[4];
#pragma unroll
            for (int k = 0; k < 4; ++k) zl[k] = *(const u32x4_t*)(ZP + ((size_t)b * LP + 128 * c + rr + 16 * (k0 + k)) * NIN + C_Z + h * 64 + pt * 32 + cq * 8);
#pragma unroll
            for (int k = 0; k < 4; ++k) *(LAS u32x4_t*)(ZT + (rr + 16 * (k0 + k)) * 32 + cq * 8) = zl[k];
        }
        LDS_WAIT();
#pragma unroll
        for (int lt = 0; lt < 4; ++lt) {
            float sq = 0.f;
#pragma unroll
            for (int q = 0; q < 4; ++q) { const u32x2_t z4 = *(const LAS u32x2_t*)(ZT + (lt * 32 + l31) * 32 + 8 * q + 4 * half);
                const float y0 = acc[pt][lt][4 * q] * siluf(bf_lo(z4.x)), y1 = acc[pt][lt][4 * q + 1] * siluf(bf_hi(z4.x)), y2 = acc[pt][lt][4 * q + 2] * siluf(bf_lo(z4.y)), y3 = acc[pt][lt][4 * q + 3] * siluf(bf_hi(z4.y));
                acc[pt][lt][4 * q] = y0; acc[pt][lt][4 * q + 1] = y1; acc[pt][lt][4 * q + 2] = y2; acc[pt][lt][4 * q + 3] = y3;
                sq += (y0 * y0 + y1 * y1) + (y2 * y2 + y3 * y3); }
            ssq[lt] += sq;
        }
        LDS_WAIT();
    }
#pragma unroll
    for (int lt = 0; lt < 4; ++lt) ssq[lt] += __shfl_xor(ssq[lt], 32);
    LAS float* RED = (LAS float*)(lds + SSD_RED);
    if (half == 0) {
#pragma unroll
        for (int lt = 0; lt < 4; ++lt) RED[w * 128 + lt * 32 + l31] = ssq[lt];
    }
    LDS_WAIT();
    __syncthreads();
    float rstd[4];
#pragma unroll
    for (int lt = 0; lt < 4; ++lt) { float tot = 0.f;
#pragma unroll
        for (int ww = 0; ww < 8; ++ww) tot += RED[ww * 128 + lt * 32 + l31];
        rstd[lt] = 1.f / sqrtf(tot * (1.f / 512.f) + RMS_EPS); }
    const float* ng = p.in[10];
    bf16_t* AY = (bf16_t*)(p.ws + WS_AY);
#pragma unroll
    for (int pt = 0; pt < 2; ++pt) {
#pragma unroll
        for (int q = 0; q < 4; ++q) { const f32x4_t g4 = *(const f32x4_t*)(ng + h * 64 + pt * 32 + 8 * q + 4 * half);
#pragma unroll
            for (int lt = 0; lt < 4; ++lt)
                *(LAS u32x2_t*)(ZT + (lt * 32 + l31) * 32 + 8 * q + 4 * half) = (u32x2_t){cvtpk(acc[pt][lt][4 * q] * rstd[lt] * g4[0], acc[pt][lt][4 * q + 1] * rstd[lt] * g4[1]), cvtpk(acc[pt][lt][4 * q + 2] * rstd[lt] * g4[2], acc[pt][lt][4 * q + 3] * rstd[lt] * g4[3])}; }
        LDS_WAIT();
#pragma unroll
        for (int k = 0; k < 8; ++k) *(u32x4_t*)(AY + ((size_t)b * SEQ + 128 * (c - 1) + rr + 16 * k) * 3072 + 1024 + h * 64 + pt * 32 + cq * 8) = *(const LAS u32x4_t*)(ZT + (rr + 16 * k) * 32 + cq * 8);
        LDS_WAIT();
    }
}

constexpr int AT_KSTR = 72;
constexpr int AT_VSTR = 388;
constexpr int AT_K = 0, AT_V = 288 * AT_KSTR * 2;
DEVINL void attn_mfma_item(const P& p, int item, LAS unsigned char* lds, int tid, int w, int lane) {
    asm volatile("" : "+v"(tid)); asm volatile("" : "+s"(w)); lane = tid & 63;
    const int n = (item & 63) + 1, kvh = (item >> 6) & 3, b = item >> 8, half = lane >> 5, l31 = lane & 31;
    const bf16_t* ZP = (const bf16_t*)(p.ws + WS_ZP);
    LAS bf16_t* Kl = (LAS bf16_t*)(lds + AT_K); LAS bf16_t* Vt = (LAS bf16_t*)(lds + AT_V);
    __syncthreads();
    for (int ci = tid; ci < 288 * 8; ci += 512) {
        const int kk = ci >> 3, dc = ci & 7;
        u32x4_t kv = (u32x4_t){0u, 0u, 0u, 0u}, vv = (u32x4_t){0u, 0u, 0u, 0u};
        if (kk < 272) { const int pr = kk < 256 ? 128 * (n - 1) + kk : 112 + (kk - 256);
            const bf16_t* rp = ZP + ((size_t)b * LP + pr) * NIN + kvh * 64 + dc * 8;
            kv = *(const u32x4_t*)(rp + C_K); vv = *(const u32x4_t*)(rp + C_V); }
        *(LAS u32x4_t*)(Kl + kk * AT_KSTR + dc * 8) = kv;
        LAS bf16_t* vd = Vt + (dc * 8) * AT_VSTR + kk;
        vd[0] = (bf16_t)(vv.x & 0xffffu); vd[AT_VSTR] = (bf16_t)(vv.x >> 16); vd[2 * AT_VSTR] = (bf16_t)(vv.y & 0xffffu); vd[3 * AT_VSTR] = (bf16_t)(vv.y >> 16);
        vd[4 * AT_VSTR] = (bf16_t)(vv.z & 0xffffu); vd[5 * AT_VSTR] = (bf16_t)(vv.z >> 16); vd[6 * AT_VSTR] = (bf16_t)(vv.w & 0xffffu); vd[7 * AT_VSTR] = (bf16_t)(vv.w >> 16);
    }
    LDS_WAIT();
    __syncthreads();
    const int g = w >> 1, qh = w & 1, hq = kvh * 4 + g;
    const float sink = p.in[11][hq];
    bf16_t* AY = (bf16_t*)(p.ws + WS_AY);
#pragma unroll 1
    for (int q2 = 0; q2 < 2; ++q2) {
        const int qt = 2 * qh + q2;
        const bf16_t* qp = ZP + ((size_t)b * LP + 128 * n + 32 * qt + l31) * NIN + C_Q + hq * 64 + 8 * half;
        bf16x8 qf[4];
#pragma unroll
        for (int ks = 0; ks < 4; ++ks) qf[ks] = *(const bf16x8*)(qp + ks * 16);
        f32x16 o0, o1;
#pragma unroll
        for (int r = 0; r < 16; ++r) { o0[r] = 0.f; o1[r] = 0.f; }
        float m = sink, lsum = (half == 0) ? 1.f : 0.f;
        const int iq = 32 * qt + l31;
#pragma unroll 1
        for (int t = 0; t < 6; ++t) {
            const int jt = (t < 5) ? qt + t : 8;
            if (n == 1 && jt < 4) continue;
            f32x16 st;
#pragma unroll
            for (int r = 0; r < 16; ++r) st[r] = 0.f;
#pragma unroll
            for (int ks = 0; ks < 4; ++ks) { const bf16x8 kf = *(const LAS bf16x8*)(Kl + (jt * 32 + l31) * AT_KSTR + ks * 16 + 8 * half); st = MFMA32(kf, qf[ks], st); }
            float tmax = -1e30f;
#pragma unroll
            for (int r = 0; r < 16; ++r) { const int kk = jt * 32 + (r & 3) + 8 * (r >> 2) + 4 * half;
                const bool ok = (jt == 8) ? (kk < 272) : (kk >= iq + 1 && kk <= iq + 128);
                st[r] = ok ? st[r] * 0.125f : -1e30f; tmax = fmaxf(tmax, st[r]); }
            tmax = fmaxf(tmax, __shfl_xor(tmax, 32));
            const float mn = fmaxf(m, tmax), al = __expf(m - mn);
            float ps = 0.f; float pv[16];
#pragma unroll
            for (int r = 0; r < 16; ++r) { pv[r] = __expf(st[r] - mn); ps += pv[r]; }
            lsum = lsum * al + ps; m = mn;
#pragma unroll
            for (int r = 0; r < 16; ++r) { o0[r] *= al; o1[r] *= al; }
            const bf16x8 pb0 = pack8(pv), pb1 = pack8(pv + 8);
#pragma unroll
            for (int s2 = 0; s2 < 2; ++s2) {
                const LAS bf16_t* v0 = Vt + l31 * AT_VSTR + jt * 32 + 16 * s2 + 4 * half; const LAS bf16_t* v1 = v0 + 32 * AT_VSTR;
                const u32x2_t a00 = *(const LAS u32x2_t*)(v0), a01 = *(const LAS u32x2_t*)(v0 + 8), a10 = *(const LAS u32x2_t*)(v1), a11 = *(const LAS u32x2_t*)(v1 + 8);
                const u32x4_t A0 = (u32x4_t){a00.x, a00.y, a01.x, a01.y}, A1 = (u32x4_t){a10.x, a10.y, a11.x, a11.y};
                o0 = MFMA32(__builtin_bit_cast(bf16x8, A0), s2 == 0 ? pb0 : pb1, o0);
                o1 = MFMA32(__builtin_bit_cast(bf16x8, A1), s2 == 0 ? pb0 : pb1, o1);
            }
        }
        lsum += __shfl_xor(lsum, 32);
        const float il = 1.f / lsum;
        const size_t orow = ((size_t)b * SEQ + 128 * (n - 1) + 32 * qt + l31) * 3072 + hq * 64;
#pragma unroll
        for (int q = 0; q < 4; ++q) {
            *(uint2*)(AY + orow + 8 * q + 4 * half) = make_uint2(cvtpk(o0[4 * q] * il, o0[4 * q + 1] * il), cvtpk(o0[4 * q + 2] * il, o0[4 * q + 3] * il));
            *(uint2*)(AY + orow + 32 + 8 * q + 4 * half) = make_uint2(cvtpk(o1[4 * q] * il, o1[4 * q + 1] * il), cvtpk(o1[4 * q + 2] * il, o1[4 * q + 3] * il));
        }
    }
}

constexpr int LDS_BYTES = 163840, CTLZ_OFF = LDS_BYTES - 1024, MISC_OFF = CTLZ_OFF + 320;
static_assert(SSD_WV + 8 * SSD_WV_BYTES <= CTLZ_OFF && AT_V + 64 * AT_VSTR * 2 <= CTLZ_OFF && pg8::STAGE_BYTES <= CTLZ_OFF, "LDS map");
constexpr int NPHASE = 11;
__global__ void __launch_bounds__(512, 2) mega_fwd(P p) {
    extern __shared__ __attribute__((aligned(16))) unsigned char lds_raw[];
    LAS unsigned char* lds = (LAS unsigned char*)lds_raw;
    volatile LAS unsigned* MISC = (volatile LAS unsigned*)(lds + MISC_OFF);
    const int tid = threadIdx.x, lane = tid & 63, wave = __builtin_amdgcn_readfirstlane(tid >> 6);
    const int G = gridDim.x, bx = blockIdx.x;
    const int vcu = (G % 8 == 0) ? (bx % 8) * (G / 8) + bx / 8 : bx;
    const int gw = bx * 8 + wave, NGW = G * 8;
    unsigned char* ws = p.ws;
    for (int u = tid; u < (LDS_BYTES - CTLZ_OFF) / 4; u += 512) ((LAS unsigned*)(lds + CTLZ_OFF))[u] = 0u;
    __syncthreads();
    const bool one_launch = (p.ph_hi - p.ph_lo) > 1;
    XcdBarrier bar; bar.bar = (unsigned*)(ws + WS_CTL); bar.x = 0; bar.st = nullptr;
    if (one_launch) bar = xcd_barrier_post((unsigned*)(ws + WS_CTL), MISC + 8);
#ifndef PHASE_MASK
#define PHASE_MASK 0xFFFF
#endif
#define IN(k) (((PHASE_MASK >> (k)) & 1) && p.ph_lo <= (k) && (k) < p.ph_hi)
#define SEAM(k) do { if (IN(k) && IN((k) + 1)) xcd_barrier(bar); } while (0)
#define REP(k) for (int rep_ = 0; rep_ < 1 + ((REPEAT_MASK >> (k)) & 1); ++rep_, (void)((rep_ < 1 + ((REPEAT_MASK >> (k)) & 1)) ? (xcd_barrier(bar), 0) : 0))

    if (IN(0)) REP(0) {
        {   constexpr int NDENSE_ITEMS = 32 * 344 + 16 * 64 + 32 * 64 + 32 * 64;
            const int niter = (MP + NGW - 1) / NGW, tpw = (NDENSE_ITEMS + NGW - 1) / NGW, tpi = (tpw + niter - 1) / niter;
            float4 g0r[8], b0r[8];
#pragma unroll
            for (int j = 0; j < 8; ++j) { g0r[j] = ((const float4*)p.in[2])[lane + 64 * j]; b0r[j] = ((const float4*)p.in[3])[lane + 64 * j]; }
            for (int i = 0; i < niter; ++i) {
                const int R = gw + i * NGW; if (R < MP) ln0_row(p, R, lane, g0r, b0r);
                phase_weights(p, (LAS float*)(lds + wave * 16384), gw, NGW, lane, false, i * tpi * NGW, (i + 1) * tpi * NGW);
            } }
        for (int idx = bx * 512 + tid; idx < DM * NE; idx += G * 512) { const int i = idx >> 6, cc = idx & 63; ((float*)(ws + OFF_WREG))[((cc >> 3) * DM + i) * 8 + (cc & 7)] = p.in[19][idx]; }
    }
    SEAM(0);
    for (int eb_ = 0; eb_ < EXTRA_BARRIERS; ++eb_) xcd_barrier(bar);
    if (IN(1)) REP(1) {
        pg8::Gemm g{(const bf16_t*)(ws + WS_H0), (const bf16_t*)(ws + WS_WIN), DM, DM, DM};
        pg8::StaticOrder S; S.init(g, MP, NIN, G, bx, WGM_INPROJ);
        pg8::EpiBf16Plain E{(bf16_t*)(ws + WS_ZP), (size_t)NIN};
        pg8::gemm_phase<pg8::EpiBf16Plain, pg8::StaticOrder, true, false>(lds, g, S, E);
    }
    SEAM(1);
    if (IN(2)) REP(2) {
        for (int pc = gw; pc < 256; pc += NGW) conv_c64_piece(p, pc, lds, wave, lane);
        for (int j = vcu; j < 512; j += G) {
            conv_pre_item(p, j >> 8, (j >> 2) & 63, j & 3, lds, tid, wave, lane);
            ssd1_item(p, j, lds, tid, wave, lane);
        }
        for (int it = vcu; it < 512; it += G) attn_mfma_item(p, it, lds, tid, wave, lane);
    }
    SEAM(2);
    if (IN(3)) REP(3) { for (int gt = bx * 512 + tid; gt < (int)(2 * S_CHUNK / 4); gt += G * 512) ssd2_scan(p, gt); }
    SEAM(3);
    if (IN(4)) REP(4) { for (int it = vcu; it < 512; it += G) ssd3_item(p, it, lds, tid, wave, lane); }
    SEAM(4);
    if (IN(5)) {
        pg8::Gemm g{(const bf16_t*)(ws + WS_AY), (const bf16_t*)(ws + WS_WBRA), 3072, 3072, 3072};
        pg8::StaticOrder S; S.init(g, MR, DM, G, bx, WGM_DENSE);
        pg8::EpiBrFused E{(const bf16_t*)(ws + WS_ZP), (bf16_t*)(ws + WS_MERGED)};
        pg8::gemm_phase<pg8::EpiBrFused, pg8::StaticOrder, true, false, 16>(lds, g, S, E);
    }
    SEAM(5);
    if (IN(6)) {
        pg8::Gemm g{(const bf16_t*)(ws + WS_MERGED), (const bf16_t*)(ws + WS_WO), DM, DM, DM};
        pg8::StaticOrder S; S.init(g, MR, DM, G, bx, WGM_DENSE);
        pg8::EpiWo E{(float*)(ws + WS_U), (const bf16_t*)(ws + WS_H0)};
        pg8::gemm_phase<pg8::EpiWo, pg8::StaticOrder, true, false>(lds, g, S, E);
    }
    SEAM(6);
    if (IN(7)) {
        LAS float* wrgl = (LAS float*)(lds + 8 * 8448);
        __syncthreads();
        for (int u = tid; u < DM * 8 / 4; u += 512) *(LAS pg8::f32x4*)(wrgl + 4 * u) = *(const pg8::f32x4*)(p.in[17] + 4 * u);
        LDS_WAIT(); __syncthreads();
        {   const int niter = (MR + NGW - 1) / NGW;
            LAS int* res = (LAS int*)(lds + 8 * 8448 + DM * 8 * 4);
            float4 vin[8], g1r[8], b1r[8];
#pragma unroll
            for (int j = 0; j < 8; ++j) { g1r[j] = ((const float4*)p.in[15])[lane + 64 * j]; b1r[j] = ((const float4*)p.in[16])[lane + 64 * j]; }
            if (gw < MR) {
#pragma unroll
                for (int j = 0; j < 8; ++j) vin[j] = ((const float4*)((const float*)(ws + WS_U) + (size_t)gw * DM))[lane + 64 * j]; }
            for (int i = 0; i < niter; ++i) {
                const int r = gw + i * NGW, rn = (i + 1 < niter && r + NGW < MR) ? r + NGW : -1;
                if (r < MR) ln1_router_row<true>(p, r, rn, vin, g1r, b1r, lane, (LAS float*)(lds + wave * 8448), wrgl, res + (wave * niter + i) * 4);
#if !MOE_WF32
                { constexpr int NMOE_ITEMS = 64 * 32 * 32 + 64 * 8 * 64; const int tpw = (NMOE_ITEMS + NGW - 1) / NGW, tpi = (tpw + niter - 1) / niter;
                  phase_weights(p, (LAS float*)(lds + wave * 8448), gw, NGW, lane, true, i * tpi * NGW, (i + 1) * tpi * NGW); }
#endif
            }
            LAS int* lcnt = (LAS int*)lds; LAS int* lbase = lcnt + 64; LAS int* lp = lcnt + 128;
            int* cnt = (int*)(ws + OFF_CNT); int* list_ent = (int*)(ws + WS_LIST); float* list_w = (float*)(ws + WS_LISTW);
            LDS_WAIT(); __syncthreads();
            if (tid < 64) lcnt[tid] = 0;
            LDS_WAIT(); __syncthreads();
            const int nent = 16 * niter;
            for (int t = tid; t < nent; t += 512) { const int w = t / (2 * niter), i = (t >> 1) % niter, k = t & 1, r = bx * 8 + w + i * NGW;
                if (r < MR) lp[t] = __hip_atomic_fetch_add(lcnt + res[(w * niter + i) * 4 + k], 1, __ATOMIC_RELAXED, __HIP_MEMORY_SCOPE_WORKGROUP); }
            LDS_WAIT(); __syncthreads();
            if (tid < 64) { const int c = lcnt[tid]; lbase[tid] = c ? atomicAdd(&cnt[tid], c) : 0; }
            LDS_WAIT(); __syncthreads();
            for (int t = tid; t < nent; t += 512) { const int w = t / (2 * niter), i = (t >> 1) % niter, k = t & 1, r = bx * 8 + w + i * NGW;
                if (r < MR) { const int e = res[(w * niter + i) * 4 + k], pos = lbase[e] + lp[t];
                    list_ent[e * MR + pos] = r * 2 + k; list_w[e * MR + pos] = __int_as_float(res[(w * niter + i) * 4 + 2 + k]); } }
        }
    }
    SEAM(7);
    LAS int* tl_e = (LAS int*)(lds + 131072); LAS int* tl_f = tl_e + MOE_MAXT; LAS int* tl_n = tl_f + MOE_MAXT; LAS int* tl_x = tl_n + MOE_MAXT;
    if (IN(8) || IN(9)) {
        __syncthreads();
        if (tid < NE) tl_x[tid] = (((const int*)(ws + OFF_CNT))[tid] + MOE_TILE - 1) / MOE_TILE;
        LDS_WAIT(); __syncthreads();
        if (tid < NE) { int st0 = 0; for (int i = 0; i < tid; ++i) st0 += tl_x[i];
            const int cn = ((const int*)(ws + OFF_CNT))[tid], nt = tl_x[tid];
            for (int j = 0; j < nt; ++j) { tl_e[st0 + j] = tid; tl_f[st0 + j] = j * MOE_TILE; tl_n[st0 + j] = (cn - j * MOE_TILE) < MOE_TILE ? (cn - j * MOE_TILE) : MOE_TILE; }
            if (tid == NE - 1) tl_x[64] = st0 + nt; }
        LDS_WAIT(); __syncthreads();
    }
    const pg8::MoeTiles MT{tl_e, tl_f, tl_n, (const int*)(ws + WS_LIST), (const float*)(ws + WS_LISTW)};
    auto tf_plan = [&](int& R8, int& r) -> int {
        int k_ = 0; R8 = 0; r = G;
#if MOE_TAILFILL
        if ((IN(8) && IN(9)) && !((REPEAT_MASK >> 8) & 3)) {
            const int NT = tl_x[64], U8 = NT * 4, U9 = NT * 8;
            R8 = (U8 + G - 1) / G; r = U8 - (R8 - 1) * G;
            const int idle = G - r, T0 = R8 >= 2 ? ((R8 - 1) * G) / 4 : 0;
            if (idle > 0 && T0 > 0) {
                int best = 38 + 10 * ((U9 + G - 1) / G);
                for (int k = 1; k <= 8 && idle * k <= T0 * 8; ++k) { const int c10 = (10 * k > 38 ? 10 * k : 38) + 10 * ((U9 - idle * k + G - 1) / G); if (c10 < best) { best = c10; k_ = k; } }
            }
        }
#endif
        return k_; };
    if (IN(8)) REP(8) {
        const int NT = tl_x[64];
        pg8::Gemm g{(const bf16_t*)(ws + WS_H1B), (const bf16_t*)(ws + WS_WGU), DM, DM, DM};
        int R8_, r_; const int k_ = tf_plan(R8_, r_);
        pg8::MoeOrder S{4, NT * 4, G, vcu, g.A, DM, g.Bt, (size_t)1024 * DM, DM, MT, true, 0, (unsigned*)(ws + OFF_ARR), k_ > 0 ? R8_ - 2 : -1};
        pg8::EpiGateUp E{(bf16_t*)(ws + WS_HID)};
#if MOE_WF32
        const pg8::WF32 wf{p.in[21], p.in[22], (size_t)DM * DE, 128, DE};
        pg8::gemm_phase_wf32<pg8::EpiGateUp, pg8::MoeOrder, true, WF32_ROWMAP_GU, WF32_SP2S_GU, 1>(lds, g, S, E, wf);
#else
        pg8::gemm_phase<pg8::EpiGateUp, pg8::MoeOrder, true, true>(lds, g, S, E);
#endif
    }
#if PROBE_P8_TWICE
    xcd_barrier(bar);
    if (IN(8)) {
        const int NT = tl_x[64];
        pg8::Gemm g{(const bf16_t*)(ws + WS_H1B), (const bf16_t*)(ws + WS_WGU), DM, DM, DM};
        int R8_, r_; const int k_ = tf_plan(R8_, r_);
        pg8::MoeOrder S{4, NT * 4, G, vcu, g.A, DM, g.Bt, (size_t)1024 * DM, DM, MT, true, 0, (unsigned*)(ws + OFF_ARR), k_ > 0 ? R8_ - 2 : -1};
        pg8::EpiGateUp E{(bf16_t*)(ws + WS_HID)};
#if MOE_WF32
        const pg8::WF32 wf{p.in[21], p.in[22], (size_t)DM * DE, 128, DE};
        pg8::gemm_phase_wf32<pg8::EpiGateUp, pg8::MoeOrder, true, WF32_ROWMAP_GU, WF32_SP2S_GU, 1>(lds, g, S, E, wf);
#else
        pg8::gemm_phase<pg8::EpiGateUp, pg8::MoeOrder, true, true>(lds, g, S, E);
#endif
    }
#endif
    { int R8_, r_; const int k_ = tf_plan(R8_, r_);
      if (k_ > 0 && vcu >= r_) {
        if (tid == 0) { unsigned sp = 0; while (__hip_atomic_load((unsigned*)(ws + OFF_ARR), __ATOMIC_RELAXED, __HIP_MEMORY_SCOPE_AGENT) < (unsigned)G && ++sp < (1u << 22)) __builtin_amdgcn_s_sleep(2);
            __builtin_amdgcn_fence(__ATOMIC_ACQUIRE, "agent"); }
        __syncthreads();
        pg8::Gemm g{(const bf16_t*)(ws + WS_HID), (const bf16_t*)(ws + WS_WDN), DE, DE, DE};
        pg8::MoeOrder S{8, (G - r_) * k_, G - r_, vcu - r_, g.A, DE, g.Bt, (size_t)DM * DE, DE, MT, false, 0, nullptr, -1};
        pg8::EpiDown E{(bf16_t*)(ws + WS_Y), MT};
        const pg8::WF32 wf{p.in[23], p.in[23] + 128, (size_t)DE * DM, 256, DM};
        pg8::gemm_phase_wf32<pg8::EpiDown, pg8::MoeOrder, false, WF32_ROWMAP_DN, WF32_SP2S_DN>(lds, g, S, E, wf);
      } }
    SEAM(8);
    if (IN(9)) REP(9) {
        const int NT = tl_x[64];
        int R8_, r_; const int k_ = tf_plan(R8_, r_);
        pg8::Gemm g{(const bf16_t*)(ws + WS_HID), (const bf16_t*)(ws + WS_WDN), DE, DE, DE};
        pg8::MoeOrder S{8, NT * 8, G, vcu, g.A, DE, g.Bt, (size_t)DM * DE, DE, MT, false, (G - r_) * k_, nullptr, -1};
        pg8::EpiDown E{(bf16_t*)(ws + WS_Y), MT};
#if MOE_WF32
        const pg8::WF32 wf{p.in[23], p.in[23] + 128, (size_t)DE * DM, 256, DM};
        pg8::gemm_phase_wf32<pg8::EpiDown, pg8::MoeOrder, false, WF32_ROWMAP_DN, WF32_SP2S_DN>(lds, g, S, E, wf);
#else
        pg8::gemm_phase<pg8::EpiDown, pg8::MoeOrder, true, false>(lds, g, S, E);
#endif
    }
    SEAM(9);
    if (IN(10)) REP(10) { int t10 = threadIdx.x; asm volatile("" : "+v"(t10));
        const int lane10 = t10 & 63, gw10 = bx * 8 + (t10 >> 6);
        float4 g2r[8], b2r[8];
#pragma unroll
        for (int j = 0; j < 8; ++j) { g2r[j] = ((const float4*)p.in[24])[2 * (lane10 + 64 * (j >> 1)) + (j & 1)]; b2r[j] = ((const float4*)p.in[25])[2 * (lane10 + 64 * (j >> 1)) + (j & 1)]; }
        for (int r = gw10; r < MR; r += NGW) ln2_row(p, r, lane10, g2r, b2r); }
#undef IN
#undef SEAM
}

extern "C" void kernel_launch(void* const* d_in, const int* in_sizes, int n_in, void* d_out, int out_size, void* d_ws, size_t ws_size, hipStream_t stream) {
    static int grid = 0;
    if (grid == 0) {
        if (n_in != 26 || ws_size < WS_END) { fprintf(stderr, "kernel_launch: unexpected n_in %d or ws_size %zu\n", n_in, ws_size); grid = -1; return; }
        int dev = 0, cus = 0;
        if (hipGetDevice(&dev) != hipSuccess || hipDeviceGetAttribute(&cus, hipDeviceAttributeMultiprocessorCount, dev) != hipSuccess) { grid = -1; return; }
        if (hipFuncSetAttribute((const void*)mega_fwd, hipFuncAttributeMaxDynamicSharedMemorySize, LDS_BYTES) != hipSuccess) { fprintf(stderr, "kernel_launch: hipFuncSetAttribute failed\n"); grid = -1; return; }
        grid = cus;
    }
    if (grid < 0) return;
    (void)hipMemsetAsync((char*)d_ws + WS_CTL, 0, CTL_BYTES, stream);
    P a{};
    for (int i = 0; i < 26; ++i) a.in[i] = (const float*)d_in[i];
    a.out = (float*)d_out; a.ws = (unsigned char*)d_ws;
#if MK_PER_PHASE
    for (int k = 0; k < NPHASE; ++k) { a.ph_lo = k; a.ph_hi = k + 1; hipLaunchKernelGGL(mega_fwd, dim3(grid), dim3(512), LDS_BYTES, stream, a); }
#else
    a.ph_lo = 0; a.ph_hi = NPHASE;
    hipLaunchKernelGGL(mega_fwd, dim3(grid), dim3(512), LDS_BYTES, stream, a);
#endif
}
```
